# Optimizing an MI355X kernel written in HIP

```python
import math
import jax, jax.numpy as jnp
from jax import lax
import numpy as np

D_MODEL = 2048
BATCH = 1
SEQ = 8192
DEPTH = 2

D_FOURIER = D_MODEL // 4
FOURIER_GROUP = 128
N_FOURIER_GROUPS = D_FOURIER // FOURIER_GROUP
D_DIFF = D_MODEL // 2
DIFF_HEAD_DIM = 128
DIFF_HALF_DIM = DIFF_HEAD_DIM // 2
N_DIFF_HEADS = D_DIFF // DIFF_HEAD_DIM
D_GMLP = D_MODEL - D_FOURIER - D_DIFF
GMLP_GROUP = 128
N_GMLP_GROUPS = D_GMLP // GMLP_GROUP
CHUNK = 128
SPLIT_SIZES = (D_FOURIER, D_FOURIER, D_DIFF, D_DIFF, D_DIFF, D_DIFF, D_GMLP, D_GMLP, D_GMLP)
D_IN = sum(SPLIT_SIZES)
N_BUCKETS = 32
MAX_DISTANCE = 128
Q_BLOCK = 128
EPS = 1e-6

kernel_name = "hybrid_fourier_diffattn_sgu_encoder"


def rms_norm(x, g):
    xf = x.astype(jnp.float32)
    y = xf * lax.rsqrt(jnp.mean(xf * xf, axis=-1, keepdims=True) + EPS)
    return (y * g.astype(jnp.float32)).astype(x.dtype)


def t5_bucket(rel):
    nb = N_BUCKETS // 2
    ret = (rel > 0).astype(jnp.int32) * nb
    n = jnp.abs(rel)
    max_exact = nb // 2
    nf = jnp.maximum(n, 1).astype(jnp.float32)
    large = max_exact + (jnp.log(nf / max_exact) / math.log(MAX_DISTANCE / max_exact)
                         * (nb - max_exact)).astype(jnp.int32)
    large = jnp.minimum(large, nb - 1)
    return ret + jnp.where(n < max_exact, n, large)


def fourier_mix(xa, w_f):
    b, s, _ = xa.shape
    xg = xa.astype(jnp.float32).reshape(b, s, N_FOURIER_GROUPS, FOURIER_GROUP)
    f = jnp.fft.fft2(xg, axes=(1, 3), norm="ortho").real
    f = f.reshape(b, s, D_FOURIER).astype(xa.dtype)
    return f @ w_f


def diff_attention(q, k, v, rel_bias, lam, out_gain, lambda_init):
    b, s, _ = q.shape
    scale = DIFF_HALF_DIM ** -0.5
    q = q.reshape(b, s, N_DIFF_HEADS, 2, DIFF_HALF_DIM) * scale
    k = k.reshape(b, s, N_DIFF_HEADS, 2, DIFF_HALF_DIM)
    v = v.reshape(b, s, N_DIFF_HEADS, DIFF_HEAD_DIM)
    n_blocks = s // Q_BLOCK
    qb = q.reshape(b, n_blocks, Q_BLOCK, N_DIFF_HEADS, 2, DIFF_HALF_DIM).transpose(1, 0, 2, 3, 4, 5)
    starts = jnp.arange(n_blocks, dtype=jnp.int32) * Q_BLOCK
    k_pos = jnp.arange(s, dtype=jnp.int32)

    def block(args):
        q_blk, start = args
        logits = jnp.einsum('bqhcd,bkhcd->bhcqk', q_blk, k,
                            preferred_element_type=jnp.float32)
        q_pos = start + jnp.arange(Q_BLOCK, dtype=jnp.int32)
        bucket = t5_bucket(k_pos[None, :] - q_pos[:, None])
        bias = jnp.take(rel_bias, bucket, axis=0).astype(jnp.float32).transpose(2, 0, 1)
        p = jax.nn.softmax(logits + bias[None, :, None], axis=-1)
        w = p[:, :, 0] - lam * p[:, :, 1]
        return jnp.einsum('bhqk,bkhd->bqhd', w.astype(v.dtype), v)

    o = lax.map(block, (qb, starts))
    o = o.transpose(1, 0, 2, 3, 4).reshape(b, s, N_DIFF_HEADS, DIFF_HEAD_DIM)
    o = rms_norm(o, out_gain.reshape(N_DIFF_HEADS, DIFF_HEAD_DIM)) * (1.0 - lambda_init)
    return o.reshape(b, s, D_DIFF)


def spatial_gating(u, v, v_gain, w_s, b_s):
    b, s, _ = u.shape
    vg = rms_norm(v.reshape(b, s, N_GMLP_GROUPS, GMLP_GROUP),
                  v_gain.reshape(N_GMLP_GROUPS, GMLP_GROUP))
    vg = vg.reshape(b, s // CHUNK, CHUNK, N_GMLP_GROUPS, GMLP_GROUP)
    mixed = jnp.einsum('gpq,bnqgc->bnpgc', w_s, vg) + b_s.T[None, None, :, :, None]
    return u * mixed.reshape(b, s, D_GMLP)


def setup_inputs(seed: int = 0) -> dict:
    key = jax.random.key(seed)
    ks = jax.random.split(key, 13)
    nrm = jax.random.normal
    x = nrm(ks[0], (BATCH, SEQ, D_MODEL), jnp.float32)
    w_in = nrm(ks[1], (DEPTH, D_MODEL, D_IN), jnp.float32) * D_MODEL ** -0.5
    pre_gain = 1.0 + 0.02 * nrm(ks[2], (DEPTH, D_MODEL), jnp.float32)
    post_gain = 1.0 + 0.02 * nrm(ks[3], (DEPTH, D_MODEL), jnp.float32)
    w_fourier = nrm(ks[4], (DEPTH, D_FOURIER, D_FOURIER), jnp.float32) * D_FOURIER ** -0.5
    lambda_qk = 0.1 * nrm(ks[5], (DEPTH, 4, DIFF_HALF_DIM), jnp.float32)
    diff_out_gain = 1.0 + 0.02 * nrm(ks[6], (DEPTH, D_DIFF), jnp.float32)
    sg_v_gain = 1.0 + 0.02 * nrm(ks[7], (DEPTH, D_GMLP), jnp.float32)
    w_spatial = nrm(ks[8], (DEPTH, N_GMLP_GROUPS, CHUNK, CHUNK), jnp.float32) * CHUNK ** -0.5
    b_spatial = 1.0 + 0.02 * nrm(ks[9], (DEPTH, N_GMLP_GROUPS, CHUNK), jnp.float32)
    w_out = nrm(ks[10], (DEPTH, D_MODEL, D_MODEL), jnp.float32) * D_MODEL ** -0.5
    rel_bias = 0.5 * nrm(ks[11], (N_BUCKETS, N_DIFF_HEADS), jnp.float32)
    return {"x": x, "w_in": w_in, "pre_gain": pre_gain, "post_gain": post_gain,
            "w_fourier": w_fourier, "lambda_qk": lambda_qk, "diff_out_gain": diff_out_gain,
            "sg_v_gain": sg_v_gain, "w_spatial": w_spatial, "b_spatial": b_spatial,
            "w_out": w_out, "rel_bias": rel_bias}


def reference(x, w_in, pre_gain, post_gain, w_fourier, lambda_qk, diff_out_gain,
              sg_v_gain, w_spatial, b_spatial, w_out, rel_bias):
    split_points = [int(o) for o in np.cumsum(SPLIT_SIZES)[:-1]]
    for l in range(DEPTH):
        lambda_init = 0.8 - 0.6 * math.exp(-0.3 * l)
        h = rms_norm(x, pre_gain[l])
        proj = h @ w_in[l]
        a_in, a_gate, q, k, v, b_gate, u, v_sg, c_gate = jnp.split(proj, split_points, axis=-1)
        y_a = fourier_mix(a_in, w_fourier[l])
        lq = lambda_qk[l].astype(jnp.float32)
        lam = jnp.exp(jnp.sum(lq[0] * lq[1])) - jnp.exp(jnp.sum(lq[2] * lq[3])) + lambda_init
        y_b = diff_attention(q, k, v, rel_bias, lam, diff_out_gain[l], lambda_init)
        y_c = spatial_gating(u, v_sg, sg_v_gain[l], w_spatial[l], b_spatial[l])
        y = jnp.concatenate([y_a * jax.nn.silu(a_gate),
                             y_b * jax.nn.silu(b_gate),
                             y_c * jax.nn.silu(c_gate)], axis=-1) @ w_out[l]
        x = x + rms_norm(y, post_gain[l])
    return x
```

```cpp
#include <hip/hip_runtime.h>
#include <cstdio>
#include <cstdint>
namespace pg8 {
#define PG8_LAS __attribute__((address_space(3)))
typedef unsigned short bf16_t;
typedef short bf16x8 __attribute__((ext_vector_type(8)));
typedef float f32x4 __attribute__((ext_vector_type(4)));
typedef unsigned u32x4 __attribute__((ext_vector_type(4)));
constexpr int BM = 256, BK = 64, HALF = 128, HTB = HALF * BK * 2  , STAGE_BYTES = 8 * HTB, NXCD = 8, WGM = 8;

__host__ __device__ __forceinline__ int lds_byte(int r, int c) { const int st = (r >> 4) * 2 + (c >> 5), rr = r & 15, cc = c & 31, ob = rr * 64 + cc * 2; return st * 1024 + (ob ^ (((ob >> 9) & 1) << 5)); }
__host__ __device__ __forceinline__ void stage_rc(int b, int& R, int& C) { const int st = b / 1024, sb = b % 1024, swz = sb ^ (((sb >> 9) & 1) << 5); R = (st >> 1) * 16 + swz / 64; C = (st & 1) * 32 + (swz % 64) / 2; }
__host__ __device__ __forceinline__ int perm32(int rho) { const int n = rho >> 4, i = rho & 15; return 8 * (i >> 2) + 4 * n + (i & 3); }

struct Unit { int pm, pn; };
struct Gemm { const bf16_t* A; const bf16_t* Bt; int M, N, K; };

struct StaticOrder {
    int nM, nN, nwg, G, c;
    __host__ __device__ void init(int M, int N, int G_, int c_) { nM = M / BM; nN = N / BM; nwg = nM * nN; G = G_; c = c_; }
    __host__ __device__ bool next(int i, Unit& u) const {
        const long L = (long)i * G + c; if (L >= nwg) return false;
        int wgid = (int)L; { const int q = nwg / NXCD, r = nwg % NXCD, xcd = wgid % NXCD, off = wgid / NXCD; wgid = (xcd < r ? xcd * (q + 1) : r * (q + 1) + (xcd - r) * q) + off; }
        const int nig = WGM * nN, gid = wgid / nig, fm = gid * WGM, gsz = (nM - fm) < WGM ? (nM - fm) : WGM;
        u.pm = fm + ((wgid % nig) % gsz); u.pn = (wgid % nig) / gsz; return true;
    }
    __device__ __forceinline__ void a_ready(const Unit&) const {}
    __device__ __forceinline__ void done(const Unit&) const {}
};

__device__ __forceinline__ unsigned cvt_pk_bf16(float lo, float hi) { unsigned r; asm volatile("v_cvt_pk_bf16_f32 %0, %1, %2" : "=v"(r) : "v"(lo), "v"(hi)); return r; }
struct EpiBf16 {
    static constexpr bool PERM = true, AFTER_DRAIN = false;
    bf16_t* O; int ldc;
    __device__ __forceinline__ void operator()(const f32x4 (&acc)[2][2][4][2], const Unit& u, int wr, int wc, int fr, int fq) const {
        const int row0 = u.pm * BM + wr * 64 + fr; const int col0 = u.pn * BM + wc * 32 + 8 * fq;
#pragma unroll
        for (int ai = 0; ai < 2; ++ai)
#pragma unroll
            for (int m = 0; m < 4; ++m) { bf16_t* rowp = O + (size_t)(row0 + ai * HALF + m * 16) * ldc + col0;
#pragma unroll
                for (int bj = 0; bj < 2; ++bj) { const f32x4 v0 = acc[ai][bj][m][0], v1 = acc[ai][bj][m][1];
                    u32x4 w; w.x = cvt_pk_bf16(v0[0], v0[1]); w.y = cvt_pk_bf16(v0[2], v0[3]); w.z = cvt_pk_bf16(v1[0], v1[1]); w.w = cvt_pk_bf16(v1[2], v1[3]);
                    *(u32x4*)(rowp + bj * HALF) = w; } }
    }
};
struct EpiF32 {
    static constexpr bool PERM = false, AFTER_DRAIN = false;
    float* C; int ldc;
    __device__ __forceinline__ void operator()(const f32x4 (&acc)[2][2][4][2], const Unit& u, int wr, int wc, int fr, int fq) const {
        const int row0 = u.pm * BM + wr * 64 + fr, col0 = u.pn * BM + wc * 32 + 4 * fq;
#pragma unroll
        for (int ai = 0; ai < 2; ++ai)
#pragma unroll
            for (int m = 0; m < 4; ++m) { float* rowp = C + (size_t)(row0 + ai * HALF + m * 16) * ldc + col0;
#pragma unroll
                for (int bj = 0; bj < 2; ++bj)
#pragma unroll
                    for (int n = 0; n < 2; ++n) *(f32x4*)(rowp + bj * HALF + n * 16) = acc[ai][bj][m][n]; }
    }
};
template <class Epi, class Sched, bool ALIGN_EPI = false, bool SP2 = false>
__device__ __forceinline__ void gemm_phase(PG8_LAS unsigned char* lds, const Gemm g, const Sched& S, const Epi& E) {
    const int tid = threadIdx.x, wid = __builtin_amdgcn_readfirstlane(tid >> 6), lane = tid & 63, wr = wid >> 2, wc = wid & 3, fr = lane & 15, fq = lane >> 4;
    const int K = g.K, nt = K / BK;
    unsigned voffA[2], voffB[2];
#pragma unroll
    for (int i = 0; i < 2; ++i) { int R, C; stage_rc(tid * 16 + i * 8192, R, C); const int Rb = Epi::PERM ? ((R & ~31) + perm32(R & 31)) : R;
        voffA[i] = (unsigned)(R * K + C) * 2u; voffB[i] = (unsigned)(Rb * K + C) * 2u; }
    const size_t kstep = (size_t)(BK * 2);
    const size_t hstep = (size_t)HALF * K * 2;
    const size_t tstep = 2 * hstep;
    const unsigned ldsw = (unsigned)wid * 1024u;
    const int aoff = lds_byte(wr * 64 + fr, fq * 8), boff = lds_byte(wc * 32 + fr, fq * 8);
#define PG8_SA(b, h) (((b) * 2 + (h)) * HTB)
#define PG8_SB(b, h) ((4 + (b) * 2 + (h)) * HTB)
#define PG8_STAGE(bufoff, gbase, voff) do { _Pragma("unroll") for (int _i = 0; _i < 2; ++_i) \
        __builtin_amdgcn_global_load_lds((const unsigned*)((const char*)(gbase) + (voff)[_i]), (PG8_LAS unsigned*)(lds + (bufoff) + ldsw + _i * 8192), 16, 0, 0); } while (0)
#define PG8_LDA(dst, b, h) do { _Pragma("unroll") for (int m = 0; m < 4; ++m) _Pragma("unroll") for (int k = 0; k < 2; ++k) dst[m][k] = *(const PG8_LAS bf16x8*)(lds + PG8_SA(b, h) + aoff + m * 2048 + k * 1024); } while (0)
#define PG8_LDB(dst, b, h) do { _Pragma("unroll") for (int n = 0; n < 2; ++n) _Pragma("unroll") for (int k = 0; k < 2; ++k) dst[n][k] = *(const PG8_LAS bf16x8*)(lds + PG8_SB(b, h) + boff + n * 2048 + k * 1024); } while (0)
#define PG8_MMA(ai, bj, At, Bt) do { __builtin_amdgcn_s_setprio(1); _Pragma("unroll") for (int m = 0; m < 4; ++m) _Pragma("unroll") for (int n = 0; n < 2; ++n) _Pragma("unroll") for (int k = 0; k < 2; ++k) \
        acc[ai][bj][m][n] = __builtin_amdgcn_mfma_f32_16x16x32_bf16(Bt[n][k], At[m][k], acc[ai][bj][m][n], 0, 0, 0); __builtin_amdgcn_s_setprio(0); } while (0)
#define PG8_WAIT_V(n) asm volatile("s_waitcnt vmcnt(" #n ")" ::: "memory")
#define PG8_WAIT_L(n) asm volatile("s_waitcnt lgkmcnt(" #n ")" ::: "memory")
#define PG8_BAR __builtin_amdgcn_s_barrier()
#define PG8_SCHED __builtin_amdgcn_sched_barrier(0)
    Unit cur, nxt; int ui = 0;
    if (!S.next(0, cur)) return;
    f32x4 acc[2][2][4][2];
#pragma unroll
    for (int a = 0; a < 2; ++a)
#pragma unroll
        for (int b = 0; b < 2; ++b)
#pragma unroll
            for (int m = 0; m < 4; ++m)
#pragma unroll
                for (int n = 0; n < 2; ++n) acc[a][b][m][n] = (f32x4){0.f, 0.f, 0.f, 0.f};
    bf16x8 At[4][2], B0[2][2], B1[2][2];
    const char* cA = (const char*)g.A + (size_t)cur.pm * tstep; const char* cB = (const char*)g.Bt + (size_t)cur.pn * tstep;
    S.a_ready(cur);
    if constexpr (SP2) {
        PG8_STAGE(PG8_SB(0, 0), cB, voffB); PG8_STAGE(PG8_SB(0, 1), cB + hstep, voffB); PG8_STAGE(PG8_SA(0, 0), cA, voffA); PG8_STAGE(PG8_SA(0, 1), cA + hstep, voffA);
        if (wr == 1) PG8_BAR;
        PG8_WAIT_V(2); PG8_BAR;
        PG8_STAGE(PG8_SB(1, 0), cB + kstep, voffB); PG8_STAGE(PG8_SA(1, 0), cA + kstep, voffA); PG8_STAGE(PG8_SB(1, 1), cB + hstep + kstep, voffB);
        PG8_WAIT_V(6); PG8_BAR;
    } else {
        PG8_STAGE(PG8_SB(0, 0), cB, voffB); PG8_STAGE(PG8_SA(0, 0), cA, voffA); PG8_STAGE(PG8_SB(0, 1), cB + hstep, voffB); PG8_STAGE(PG8_SA(0, 1), cA + hstep, voffA);
        if (wr == 1) PG8_BAR;
        PG8_WAIT_V(4); PG8_BAR;
        PG8_STAGE(PG8_SB(1, 0), cB + kstep, voffB); PG8_STAGE(PG8_SA(1, 0), cA + kstep, voffA); PG8_STAGE(PG8_SB(1, 1), cB + hstep + kstep, voffB);
        PG8_WAIT_V(6); PG8_BAR;
    }
    for (;;) {
        const bool has_next = S.next(ui + 1, nxt);
        const char* nA = has_next ? (const char*)g.A + (size_t)nxt.pm * tstep : cA; const char* nB = has_next ? (const char*)g.Bt + (size_t)nxt.pn * tstep : cB;
        for (int t = 0; t < nt; t += 2) {
            const bool last = (t == nt - 2);
            const char* a1 = cA + (size_t)(t + 1) * kstep;
            const char* a2 = last ? nA : cA + (size_t)(t + 2) * kstep; const char* b2 = last ? nB : cB + (size_t)(t + 2) * kstep;
            const char* a3 = a2 + kstep; const char* b3 = b2 + kstep;
            if (last && has_next) S.a_ready(nxt);
            if constexpr (SP2) {
            PG8_LDB(B0, 0, 0); PG8_LDB(B1, 0, 1); PG8_SCHED; PG8_LDA(At, 0, 0); PG8_STAGE(PG8_SA(1, 1), a1 + hstep, voffA);
            PG8_WAIT_V(8); PG8_WAIT_L(0); PG8_BAR; PG8_MMA(0, 0, At, B0); PG8_MMA(0, 1, At, B1); PG8_BAR; PG8_SCHED;
            PG8_LDA(At, 0, 1); PG8_STAGE(PG8_SB(0, 0), b2, voffB); PG8_STAGE(PG8_SB(0, 1), b2 + hstep, voffB); PG8_STAGE(PG8_SA(0, 0), a2, voffA);
            PG8_WAIT_V(8); PG8_WAIT_L(0); PG8_BAR; PG8_MMA(1, 0, At, B0); PG8_MMA(1, 1, At, B1); PG8_BAR; PG8_SCHED;
            PG8_LDB(B0, 1, 0); PG8_LDB(B1, 1, 1); PG8_SCHED; PG8_LDA(At, 1, 0); PG8_STAGE(PG8_SA(0, 1), a2 + hstep, voffA);
            PG8_WAIT_V(8); PG8_WAIT_L(0); PG8_BAR; PG8_MMA(0, 0, At, B0); PG8_MMA(0, 1, At, B1); PG8_BAR; PG8_SCHED;
            PG8_LDA(At, 1, 1); PG8_STAGE(PG8_SB(1, 0), b3, voffB); PG8_STAGE(PG8_SB(1, 1), b3 + hstep, voffB); PG8_STAGE(PG8_SA(1, 0), a3, voffA);
            PG8_WAIT_V(8); PG8_WAIT_L(0); PG8_BAR; PG8_MMA(1, 0, At, B0); PG8_MMA(1, 1, At, B1); PG8_BAR; PG8_SCHED;
            } else {
            PG8_LDB(B0, 0, 0); PG8_SCHED; PG8_LDA(At, 0, 0); PG8_STAGE(PG8_SA(1, 1), a1 + hstep, voffA);
            PG8_WAIT_L(8); PG8_BAR; PG8_WAIT_L(0); PG8_MMA(0, 0, At, B0); PG8_BAR; PG8_SCHED;
            PG8_LDB(B1, 0, 1); PG8_STAGE(PG8_SB(0, 0), b2, voffB);
            PG8_BAR; PG8_WAIT_L(0); PG8_MMA(0, 1, At, B1); PG8_BAR;
            PG8_LDA(At, 0, 1); PG8_STAGE(PG8_SA(0, 0), a2, voffA);
            PG8_BAR; PG8_WAIT_L(0); PG8_MMA(1, 0, At, B0); PG8_BAR; PG8_SCHED;
            PG8_STAGE(PG8_SB(0, 1), b2 + hstep, voffB);
            PG8_WAIT_V(6); PG8_BAR; PG8_MMA(1, 1, At, B1); PG8_BAR;
            PG8_LDB(B0, 1, 0); PG8_SCHED; PG8_LDA(At, 1, 0); PG8_STAGE(PG8_SA(0, 1), a2 + hstep, voffA);
            PG8_WAIT_L(8); PG8_BAR; PG8_WAIT_L(0); PG8_MMA(0, 0, At, B0); PG8_BAR; PG8_SCHED;
            PG8_LDB(B1, 1, 1); PG8_STAGE(PG8_SB(1, 0), b3, voffB);
            PG8_BAR; PG8_WAIT_L(0); PG8_MMA(0, 1, At, B1); PG8_BAR;
            PG8_LDA(At, 1, 1); PG8_STAGE(PG8_SA(1, 0), a3, voffA);
            PG8_BAR; PG8_WAIT_L(0); PG8_MMA(1, 0, At, B0); PG8_BAR; PG8_SCHED;
            PG8_STAGE(PG8_SB(1, 1), b3 + hstep, voffB);
            PG8_WAIT_V(6); PG8_BAR; PG8_MMA(1, 1, At, B1); PG8_BAR;
            }
        }
        if constexpr (ALIGN_EPI) { if (wr == 0) PG8_BAR; }
        if constexpr (!Epi::AFTER_DRAIN) { E(acc, cur, wr, wc, fr, fq); S.done(cur); }
        if (!has_next) break;
#pragma unroll
        for (int a = 0; a < 2; ++a)
#pragma unroll
            for (int b = 0; b < 2; ++b)
#pragma unroll
                for (int m = 0; m < 4; ++m)
#pragma unroll
                    for (int n = 0; n < 2; ++n) acc[a][b][m][n] = (f32x4){0.f, 0.f, 0.f, 0.f};
        cur = nxt; cA = nA; cB = nB; ++ui;
        if constexpr (ALIGN_EPI) { if (wr == 1) PG8_BAR; }
    }
    PG8_WAIT_V(0);
    if constexpr (!ALIGN_EPI) { if (wr == 0) PG8_BAR; }
    PG8_BAR;
    if constexpr (Epi::AFTER_DRAIN) { E.fused(acc, cur, wr, wc, fr, fq, lds, wid, lane); S.done(cur); }
#undef PG8_SA
#undef PG8_SB
#undef PG8_STAGE
#undef PG8_LDA
#undef PG8_LDB
#undef PG8_MMA
#undef PG8_WAIT_V
#undef PG8_WAIT_L
#undef PG8_BAR
#undef PG8_SCHED
}
}
typedef unsigned short bf16;
constexpr int S_ = 8192, DM = 2048, DIN = 6656, DF = 512, DD = 1024, DG = 512, NH = 8, DEPTH = 2;
constexpr int OFF_AIN = 0, OFF_AG = 512, OFF_Q = 1024, OFF_K = 2048, OFF_V = 3072, OFF_BG = 4096, OFF_U = 5120, OFF_VS = 5632, OFF_CG = 6144;
constexpr float EPS = 1e-6f;
constexpr float LAMBDA_INIT0 = 0.2f;
constexpr float LAMBDA_INIT1 = 0.35550906759f;
__host__ __device__ __forceinline__ float lambda_init(int l) { return l == 0 ? LAMBDA_INIT0 : LAMBDA_INIT1; }

__device__ __forceinline__ unsigned f2bf(float f) { unsigned u = __builtin_bit_cast(unsigned, f); return (u + 0x7fffu + ((u >> 16) & 1u)) >> 16; }
__device__ __forceinline__ float bf2f(unsigned short b) { return __builtin_bit_cast(float, (unsigned)b << 16); }
__device__ __forceinline__ float wave_sum(float v) {
#pragma unroll
    for (int o = 1; o < 64; o <<= 1) v += __shfl_xor(v, o);
    return v;
}
__device__ __forceinline__ float wave_max(float v) {
#pragma unroll
    for (int o = 1; o < 64; o <<= 1) v = fmaxf(v, __shfl_xor(v, o));
    return v;
}
__device__ __forceinline__ float silu(float x) { return x / (1.f + __expf(-x)); }

constexpr size_t MiB = 1u << 20;
constexpr size_t WS_CTL = 0;
constexpr size_t WS_TAB = 64 * 1024;
constexpr size_t WS_BIAS = 192 * 1024;
constexpr size_t WS_LAM = 256 * 1024;
constexpr size_t WS_RSTDSG = 512 * 1024;
constexpr size_t WS_WINT = 1 * MiB;
constexpr size_t WS_WOUTT = 54 * MiB;
constexpr size_t WS_WF2T = 70 * MiB;
constexpr size_t WS_XN = 72 * MiB;
constexpr size_t WS_PROJ = 104 * MiB;
constexpr size_t WS_TP = 208 * MiB;
constexpr size_t WS_X2 = 224 * MiB;
constexpr size_t WS_Y = 240 * MiB;
constexpr size_t WS_YOUT = 272 * MiB;
constexpr size_t WS_END = 336 * MiB;

__global__ void k_transpose(const float* __restrict__ W, bf16* __restrict__ WT, int K, int N) {
    __shared__ float t[32][33];
    const int n0 = blockIdx.x * 32, k0 = blockIdx.y * 32;
    for (int i = threadIdx.y; i < 32; i += 8) t[i][threadIdx.x] = W[(size_t)(k0 + i) * N + n0 + threadIdx.x];
    __syncthreads();
    for (int i = threadIdx.y; i < 32; i += 8) WT[(size_t)(n0 + i) * K + k0 + threadIdx.x] = (bf16)f2bf(t[threadIdx.x][i]);
}
__global__ void k_wf2(const float* __restrict__ wf, bf16* __restrict__ Wf2T) {
    const int idx = blockIdx.x * blockDim.x + threadIdx.x; if (idx >= 512 * 1024) return;
    const int j = idx >> 10, pc = idx & 1023, part = pc >> 9, c = pc & 511, g = c >> 7, n3 = c & 127;
    float acc = 0.f;
    for (int k3 = 0; k3 < 128; ++k3) { const int a = (k3 * n3) & 127; float sn, cs; sincospif((float)a * (1.f / 64.f), &sn, &cs);
        acc += (part ? sn : cs) * wf[(size_t)(g * 128 + k3) * 512 + j]; }
    Wf2T[idx] = (bf16)f2bf(acc * 9.765625e-4f);
}
__device__ __forceinline__ int t5_bucket(int rel) {
    const int ret = rel > 0 ? 16 : 0; const int n = rel < 0 ? -rel : rel;
    if (n < 8) return ret + n;
    int j = 0; while (j < 7 && (64 << (j + 1)) <= n * n) ++j;
    return ret + 8 + j;
}
__global__ void k_tables(const float* __restrict__ rel_bias, const float* __restrict__ lambda_qk, float2* __restrict__ trig, float* __restrict__ biasTab, float* __restrict__ lam) {
    const int idx = blockIdx.x * blockDim.x + threadIdx.x;
    if (idx < 8192) { float sn, cs; sincospif((float)idx * (1.f / 4096.f), &sn, &cs); trig[idx] = make_float2(cs, sn); }
    if (idx < 8 * 272) { const int h = idx / 272, i = idx % 272; int rel = i - 128; if (rel > 128) rel = 128; biasTab[idx] = rel_bias[t5_bucket(rel) * 8 + h]; }
    if (idx < 2) { const float* lq = lambda_qk + idx * 256; float a = 0.f, b = 0.f; for (int i = 0; i < 64; ++i) { a += lq[i] * lq[64 + i]; b += lq[128 + i] * lq[192 + i]; }
        lam[idx] = expf(a) - expf(b) + lambda_init(idx); }
}
__global__ void k_rmsnorm_pre(const float* __restrict__ x, const float* __restrict__ gain, bf16* __restrict__ xn) {
    const int row = blockIdx.x * (blockDim.x >> 6) + (threadIdx.x >> 6), lane = threadIdx.x & 63;
    const float4* xr = (const float4*)(x + (size_t)row * DM) + lane; const float4* gr = (const float4*)gain + lane;
    float4 v[8]; float ss = 0.f;
#pragma unroll
    for (int j = 0; j < 8; ++j) { v[j] = xr[64 * j]; ss += v[j].x * v[j].x + v[j].y * v[j].y + v[j].z * v[j].z + v[j].w * v[j].w; }
    const float rstd = rsqrtf(wave_sum(ss) * (1.f / DM) + EPS);
    uint2* o = (uint2*)(xn + (size_t)row * DM) + lane;
#pragma unroll
    for (int j = 0; j < 8; ++j) { const float4 g = gr[64 * j];
        o[64 * j] = make_uint2(f2bf(v[j].x * rstd * g.x) | (f2bf(v[j].y * rstd * g.y) << 16), f2bf(v[j].z * rstd * g.z) | (f2bf(v[j].w * rstd * g.w) << 16)); }
}
__global__ void k_post(const float* xin, const float* __restrict__ y, const float* __restrict__ gain, float* xout) {
    const int row = blockIdx.x * (blockDim.x >> 6) + (threadIdx.x >> 6), lane = threadIdx.x & 63;
    const float4* yr = (const float4*)(y + (size_t)row * DM) + lane; const float4* gr = (const float4*)gain + lane; const float4* xr = (const float4*)(xin + (size_t)row * DM) + lane;
    float4 v[8]; float ss = 0.f;
#pragma unroll
    for (int j = 0; j < 8; ++j) { v[j] = yr[64 * j]; ss += v[j].x * v[j].x + v[j].y * v[j].y + v[j].z * v[j].z + v[j].w * v[j].w; }
    const float rstd = rsqrtf(wave_sum(ss) * (1.f / DM) + EPS);
    float4* o = (float4*)(xout + (size_t)row * DM) + lane;
#pragma unroll
    for (int j = 0; j < 8; ++j) { const float4 g = gr[64 * j]; const float4 xv = xr[64 * j];
        o[64 * j] = make_float4(xv.x + v[j].x * rstd * g.x, xv.y + v[j].y * rstd * g.y, xv.z + v[j].z * rstd * g.z, xv.w + v[j].w * rstd * g.w); }
}

__global__ void k_f1_naive(const bf16* __restrict__ proj, const float2* __restrict__ trig, bf16* __restrict__ Tp) {
    const int idx = blockIdx.x * blockDim.x + threadIdx.x; const int c = idx & 511, n2 = (idx >> 9) & 63, k1 = idx >> 15;
    float tr = 0.f, ti = 0.f;
    for (int n1 = 0; n1 < 128; ++n1) { const float a = bf2f(proj[(size_t)(64 * n1 + n2) * DIN + OFF_AIN + c]); const float2 cs = trig[((n1 * k1) & 127) * 64]; tr += a * cs.x; ti -= a * cs.y; }
    const float2 tw = trig[k1 * n2];
    const float pr = tr * tw.x + ti * tw.y, pi = ti * tw.x - tr * tw.y;
    Tp[((size_t)(k1 * 64 + n2) * 2 + 0) * 512 + c] = (bf16)f2bf(pr); Tp[((size_t)(k1 * 64 + n2) * 2 + 1) * 512 + c] = (bf16)f2bf(pi);
}
__global__ void k_f2_naive(const bf16* __restrict__ Tp, const float2* __restrict__ trig, bf16* __restrict__ X2) {
    const int idx = blockIdx.x * blockDim.x + threadIdx.x; const int c = idx & 511, k2 = (idx >> 9) & 63, k1 = idx >> 15;
    float xr = 0.f, xi = 0.f;
    for (int n2 = 0; n2 < 64; ++n2) { const float tr = bf2f(Tp[((size_t)(k1 * 64 + n2) * 2 + 0) * 512 + c]), ti = bf2f(Tp[((size_t)(k1 * 64 + n2) * 2 + 1) * 512 + c]);
        const float2 cs = trig[((n2 * k2) & 63) * 128]; xr += tr * cs.x + ti * cs.y; xi += ti * cs.x - tr * cs.y; }
    X2[(size_t)(k1 * 64 + k2) * 1024 + c] = (bf16)f2bf(xr); X2[(size_t)(k1 * 64 + k2) * 1024 + 512 + c] = (bf16)f2bf(xi);
}
__global__ void k_ya_naive(const bf16* __restrict__ X2, const bf16* __restrict__ Wf2T, const bf16* __restrict__ proj, bf16* __restrict__ Y) {
    const int idx = blockIdx.x * blockDim.x + threadIdx.x; const int j = idx & 511, rho = idx >> 9, k1 = rho >> 6, k2 = rho & 63, row = k1 + 128 * k2;
    float acc = 0.f;
    for (int pc = 0; pc < 1024; ++pc) acc += bf2f(X2[(size_t)rho * 1024 + pc]) * bf2f(Wf2T[(size_t)j * 1024 + pc]);
    Y[(size_t)row * DM + j] = (bf16)f2bf(acc * silu(bf2f(proj[(size_t)row * DIN + OFF_AG + j])));
}
__global__ void k_sgu_rstd(const bf16* __restrict__ proj, float* __restrict__ rstd_sg) {
    const int idx = blockIdx.x * blockDim.x + threadIdx.x; const int g = idx & 3, pos = idx >> 2;
    float ss = 0.f; for (int c = 0; c < 128; ++c) { const float v = bf2f(proj[(size_t)pos * DIN + OFF_VS + g * 128 + c]); ss += v * v; }
    rstd_sg[idx] = rsqrtf(ss * (1.f / 128.f) + EPS);
}
__global__ void k_sgu_naive(const bf16* __restrict__ proj, const float* __restrict__ rstd_sg, const float* __restrict__ vgain, const float* __restrict__ ws, const float* __restrict__ bs, bf16* __restrict__ Y) {
    const int idx = blockIdx.x * blockDim.x + threadIdx.x; const int gc = idx & 511, p = idx >> 9, g = gc >> 7, pp = p & 127, ch = p >> 7;
    float acc = 0.f; const float gn = vgain[gc];
    for (int q = 0; q < 128; ++q) { const int pos = ch * 128 + q; acc += ws[(size_t)(g * 128 + pp) * 128 + q] * (bf2f(proj[(size_t)pos * DIN + OFF_VS + gc]) * rstd_sg[pos * 4 + g] * gn); }
    const float mixed = acc + bs[g * 128 + pp];
    const float u = bf2f(proj[(size_t)p * DIN + OFF_U + gc]);
    Y[(size_t)p * DM + 1536 + gc] = (bf16)f2bf(u * mixed * silu(bf2f(proj[(size_t)p * DIN + OFF_CG + gc])));
}
__global__ void __launch_bounds__(256) k_attn_naive(const bf16* __restrict__ proj, const float* __restrict__ biasTab, const float* __restrict__ lamp, const float* __restrict__ ogain, int layer, bf16* __restrict__ Y) {
    const int w = blockIdx.x * 4 + (threadIdx.x >> 6), lane = threadIdx.x & 63; const int h = w >> 13, q = w & 8191;
    float qv[128];
    { const bf16* qp = proj + (size_t)q * DIN + OFF_Q + h * 128;
#pragma unroll
      for (int d = 0; d < 128; ++d) qv[d] = bf2f(qp[d]) * 0.125f; }
    const float* bt = biasTab + h * 272 + 128;
    float m0 = -1e30f, m1 = -1e30f, l0 = 0.f, l1 = 0.f;
    for (int t = 0; t < 128; ++t) { const int k = t * 64 + lane; const uint4* kp = (const uint4*)(proj + (size_t)k * DIN + OFF_K + h * 128);
        float s0 = 0.f, s1 = 0.f;
#pragma unroll
        for (int i = 0; i < 16; ++i) { const uint4 kk = kp[i]; const unsigned wv[4] = {kk.x, kk.y, kk.z, kk.w};
#pragma unroll
            for (int e = 0; e < 4; ++e) { const float a = __builtin_bit_cast(float, wv[e] << 16), b = __builtin_bit_cast(float, wv[e] & 0xffff0000u);
                if (i < 8) s0 += qv[i * 8 + e * 2] * a + qv[i * 8 + e * 2 + 1] * b; else s1 += qv[i * 8 + e * 2] * a + qv[i * 8 + e * 2 + 1] * b; } }
        int rel = k - q; rel = rel < -128 ? -128 : (rel > 128 ? 128 : rel); const float b = bt[rel]; s0 += b; s1 += b;
        { const float mn = fmaxf(m0, s0); l0 = l0 * __expf(m0 - mn) + __expf(s0 - mn); m0 = mn; }
        { const float mn = fmaxf(m1, s1); l1 = l1 * __expf(m1 - mn) + __expf(s1 - mn); m1 = mn; } }
    { const float M0 = wave_max(m0), M1 = wave_max(m1); l0 = wave_sum(l0 * __expf(m0 - M0)); l1 = wave_sum(l1 * __expf(m1 - M1)); m0 = M0; m1 = M1; }
    const float lam = lamp[layer], il0 = 1.f / l0, il1 = lam / l1;
    float acc0 = 0.f, acc1 = 0.f;
    for (int t = 0; t < 128; ++t) { const int k = t * 64 + lane; const uint4* kp = (const uint4*)(proj + (size_t)k * DIN + OFF_K + h * 128);
        float s0 = 0.f, s1 = 0.f;
#pragma unroll
        for (int i = 0; i < 16; ++i) { const uint4 kk = kp[i]; const unsigned wv[4] = {kk.x, kk.y, kk.z, kk.w};
#pragma unroll
            for (int e = 0; e < 4; ++e) { const float a = __builtin_bit_cast(float, wv[e] << 16), b = __builtin_bit_cast(float, wv[e] & 0xffff0000u);
                if (i < 8) s0 += qv[i * 8 + e * 2] * a + qv[i * 8 + e * 2 + 1] * b; else s1 += qv[i * 8 + e * 2] * a + qv[i * 8 + e * 2 + 1] * b; } }
        int rel = k - q; rel = rel < -128 ? -128 : (rel > 128 ? 128 : rel); const float b = bt[rel]; s0 += b; s1 += b;
        const float wgt = __expf(s0 - m0) * il0 - __expf(s1 - m1) * il1;
        const unsigned* vp = (const unsigned*)(proj + (size_t)(t * 64) * DIN + OFF_V + h * 128) + lane;
        for (int kk = 0; kk < 64; ++kk) { const float wk = __shfl(wgt, kk); const unsigned vv = vp[(size_t)kk * (DIN / 2)];
            acc0 += wk * __builtin_bit_cast(float, vv << 16); acc1 += wk * __builtin_bit_cast(float, vv & 0xffff0000u); } }
    const float rstd = rsqrtf(wave_sum(acc0 * acc0 + acc1 * acc1) * (1.f / 128.f) + EPS) * (1.f - lambda_init(layer));
    const int col = h * 128 + 2 * lane;
    const float y0 = acc0 * rstd * ogain[col] * silu(bf2f(proj[(size_t)q * DIN + OFF_BG + col]));
    const float y1 = acc1 * rstd * ogain[col + 1] * silu(bf2f(proj[(size_t)q * DIN + OFF_BG + col + 1]));
    *(unsigned*)(Y + (size_t)q * DM + 512 + col) = f2bf(y0) | (f2bf(y1) << 16);
}
__global__ void __launch_bounds__(512, 2) k_gemm_bf16(const bf16* A, const bf16* Bt, int M, int N, int K, bf16* O, int ldc) {
    extern __shared__ __attribute__((aligned(16))) unsigned char lds[];
    pg8::Gemm g{A, Bt, M, N, K}; pg8::StaticOrder S; S.init(M, N, (int)gridDim.x, (int)blockIdx.x);
    pg8::EpiBf16 E{O, ldc};
    pg8::gemm_phase<pg8::EpiBf16, pg8::StaticOrder, true, true>((PG8_LAS unsigned char*)lds, g, S, E);
}
__global__ void __launch_bounds__(512, 2) k_gemm_f32(const bf16* A, const bf16* Bt, int M, int N, int K, float* C, int ldc) {
    extern __shared__ __attribute__((aligned(16))) unsigned char lds[];
    pg8::Gemm g{A, Bt, M, N, K}; pg8::StaticOrder S; S.init(M, N, (int)gridDim.x, (int)blockIdx.x);
    pg8::EpiF32 E{C, ldc};
    pg8::gemm_phase<pg8::EpiF32, pg8::StaticOrder, true, true>((PG8_LAS unsigned char*)lds, g, S, E);
}

extern "C" void kernel_launch(void* const* d_in, const int* in_sizes, int n_in, void* d_out, int out_size, void* d_ws, size_t ws_size, hipStream_t stream) {
    static int ok = 0;
    if (!ok) {
        if (n_in != 12 || ws_size < WS_END) { fprintf(stderr, "kernel_launch: unexpected n_in %d / ws %zu\n", n_in, ws_size); return; }
        if (hipFuncSetAttribute((const void*)k_gemm_bf16, hipFuncAttributeMaxDynamicSharedMemorySize, pg8::STAGE_BYTES) != hipSuccess ||
            hipFuncSetAttribute((const void*)k_gemm_f32, hipFuncAttributeMaxDynamicSharedMemorySize, pg8::STAGE_BYTES) != hipSuccess) { fprintf(stderr, "kernel_launch: hipFuncSetAttribute failed\n"); return; }
        ok = 1;
    }
    const float* x = (const float*)d_in[0]; const float* w_in = (const float*)d_in[1]; const float* pre_gain = (const float*)d_in[2]; const float* post_gain = (const float*)d_in[3];
    const float* w_fourier = (const float*)d_in[4]; const float* lambda_qk = (const float*)d_in[5]; const float* diff_out_gain = (const float*)d_in[6]; const float* sg_v_gain = (const float*)d_in[7];
    const float* w_spatial = (const float*)d_in[8]; const float* b_spatial = (const float*)d_in[9]; const float* w_out = (const float*)d_in[10]; const float* rel_bias = (const float*)d_in[11];
    unsigned char* ws = (unsigned char*)d_ws; float* out = (float*)d_out;
    float2* trig = (float2*)(ws + WS_TAB); float* biasTab = (float*)(ws + WS_BIAS); float* lam = (float*)(ws + WS_LAM); float* rstd_sg = (float*)(ws + WS_RSTDSG);
    bf16* WinT = (bf16*)(ws + WS_WINT); bf16* WoutT = (bf16*)(ws + WS_WOUTT); bf16* Wf2T = (bf16*)(ws + WS_WF2T); bf16* XN = (bf16*)(ws + WS_XN); bf16* PROJ = (bf16*)(ws + WS_PROJ);
    bf16* TP = (bf16*)(ws + WS_TP); bf16* X2 = (bf16*)(ws + WS_X2); bf16* Y = (bf16*)(ws + WS_Y); float* YOUT = (float*)(ws + WS_YOUT);
    for (int l = 0; l < DEPTH; ++l) {
        k_transpose<<<dim3(DIN / 32, DM / 32), dim3(32, 8), 0, stream>>>(w_in + (size_t)l * DM * DIN, WinT + (size_t)l * DIN * DM, DM, DIN);
        k_transpose<<<dim3(DM / 32, DM / 32), dim3(32, 8), 0, stream>>>(w_out + (size_t)l * DM * DM, WoutT + (size_t)l * DM * DM, DM, DM);
        k_wf2<<<2048, 256, 0, stream>>>(w_fourier + (size_t)l * DF * DF, Wf2T + (size_t)l * 512 * 1024);
    }
    k_tables<<<32, 256, 0, stream>>>(rel_bias, lambda_qk, trig, biasTab, lam);
    for (int l = 0; l < DEPTH; ++l) {
        const float* xsrc = l == 0 ? x : out;
        k_rmsnorm_pre<<<S_ / 4, 256, 0, stream>>>(xsrc, pre_gain + l * DM, XN);
        k_gemm_bf16<<<256, 512, pg8::STAGE_BYTES, stream>>>(XN, WinT + (size_t)l * DIN * DM, S_, DIN, DM, PROJ, DIN);
        k_f1_naive<<<16384, 256, 0, stream>>>(PROJ, trig, TP);
        k_f2_naive<<<16384, 256, 0, stream>>>(TP, trig, X2);
        k_ya_naive<<<16384, 256, 0, stream>>>(X2, Wf2T + (size_t)l * 512 * 1024, PROJ, Y);
        k_sgu_rstd<<<128, 256, 0, stream>>>(PROJ, rstd_sg);
        k_sgu_naive<<<16384, 256, 0, stream>>>(PROJ, rstd_sg, sg_v_gain + l * DG, w_spatial + (size_t)l * 4 * 128 * 128, b_spatial + l * 4 * 128, Y);
        k_attn_naive<<<16384, 256, 0, stream>>>(PROJ, biasTab, lam, diff_out_gain + l * DD, l, Y);
        k_gemm_f32<<<256, 512, pg8::STAGE_BYTES, stream>>>(Y, WoutT + (size_t)l * DM * DM, S_, DM, DM, YOUT, DM);
        k_post<<<S_ / 4, 256, 0, stream>>>(xsrc, YOUT, post_gain + l * DM, out);
    }
}
```

```cpp
#include <hip/hip_runtime.h>
#include <cstdio>
#include <cstdint>
namespace pg8 {
#define PG8_LAS __attribute__((address_space(3)))
typedef unsigned short bf16_t;
typedef short bf16x8 __attribute__((ext_vector_type(8)));
typedef float f32x4 __attribute__((ext_vector_type(4)));
typedef unsigned u32x4 __attribute__((ext_vector_type(4)));
constexpr int BM = 256, BK = 64, HALF = 128, HTB = HALF * BK * 2  , STAGE_BYTES = 8 * HTB, NXCD = 8, WGM = 8;

__host__ __device__ __forceinline__ int lds_byte(int r, int c) { const int st = (r >> 4) * 2 + (c >> 5), rr = r & 15, cc = c & 31, ob = rr * 64 + cc * 2; return st * 1024 + (ob ^ (((ob >> 9) & 1) << 5)); }
__host__ __device__ __forceinline__ void stage_rc(int b, int& R, int& C) { const int st = b / 1024, sb = b % 1024, swz = sb ^ (((sb >> 9) & 1) << 5); R = (st >> 1) * 16 + swz / 64; C = (st & 1) * 32 + (swz % 64) / 2; }
__host__ __device__ __forceinline__ int perm32(int rho) { const int n = rho >> 4, i = rho & 15; return 8 * (i >> 2) + 4 * n + (i & 3); }

struct Unit { int pm, pn; };
struct Gemm { const bf16_t* A; const bf16_t* Bt; int M, N, K; };

struct StaticOrder {
    int nM, nN, nwg, G, c;
    __host__ __device__ void init(int M, int N, int G_, int c_) { nM = M / BM; nN = N / BM; nwg = nM * nN; G = G_; c = c_; }
    __host__ __device__ bool next(int i, Unit& u) const {
        const long L = (long)i * G + c; if (L >= nwg) return false;
        int wgid = (int)L; { const int q = nwg / NXCD, r = nwg % NXCD, xcd = wgid % NXCD, off = wgid / NXCD; wgid = (xcd < r ? xcd * (q + 1) : r * (q + 1) + (xcd - r) * q) + off; }
        const int nig = WGM * nN, gid = wgid / nig, fm = gid * WGM, gsz = (nM - fm) < WGM ? (nM - fm) : WGM;
        u.pm = fm + ((wgid % nig) % gsz); u.pn = (wgid % nig) / gsz; return true;
    }
    __device__ __forceinline__ void a_ready(const Unit&) const {}
    __device__ __forceinline__ void done(const Unit&) const {}
};

__device__ __forceinline__ unsigned cvt_pk_bf16(float lo, float hi) { unsigned r; asm volatile("v_cvt_pk_bf16_f32 %0, %1, %2" : "=v"(r) : "v"(lo), "v"(hi)); return r; }
struct EpiBf16 {
    static constexpr bool PERM = true, AFTER_DRAIN = false;
    bf16_t* O; int ldc;
    __device__ __forceinline__ void operator()(const f32x4 (&acc)[2][2][4][2], const Unit& u, int wr, int wc, int fr, int fq) const {
        const int row0 = u.pm * BM + wr * 64 + fr; const int col0 = u.pn * BM + wc * 32 + 8 * fq;
#pragma unroll
        for (int ai = 0; ai < 2; ++ai)
#pragma unroll
            for (int m = 0; m < 4; ++m) { bf16_t* rowp = O + (size_t)(row0 + ai * HALF + m * 16) * ldc + col0;
#pragma unroll
                for (int bj = 0; bj < 2; ++bj) { const f32x4 v0 = acc[ai][bj][m][0], v1 = acc[ai][bj][m][1];
                    u32x4 w; w.x = cvt_pk_bf16(v0[0], v0[1]); w.y = cvt_pk_bf16(v0[2], v0[3]); w.z = cvt_pk_bf16(v1[0], v1[1]); w.w = cvt_pk_bf16(v1[2], v1[3]);
                    *(u32x4*)(rowp + bj * HALF) = w; } }
    }
};
struct EpiF32 {
    static constexpr bool PERM = false, AFTER_DRAIN = false;
    float* C; int ldc;
    __device__ __forceinline__ void operator()(const f32x4 (&acc)[2][2][4][2], const Unit& u, int wr, int wc, int fr, int fq) const {
        const int row0 = u.pm * BM + wr * 64 + fr, col0 = u.pn * BM + wc * 32 + 4 * fq;
#pragma unroll
        for (int ai = 0; ai < 2; ++ai)
#pragma unroll
            for (int m = 0; m < 4; ++m) { float* rowp = C + (size_t)(row0 + ai * HALF + m * 16) * ldc + col0;
#pragma unroll
                for (int bj = 0; bj < 2; ++bj)
#pragma unroll
                    for (int n = 0; n < 2; ++n) *(f32x4*)(rowp + bj * HALF + n * 16) = acc[ai][bj][m][n]; }
    }
};
template <class Epi, class Sched, bool ALIGN_EPI = false, bool SP2 = false>
__device__ __forceinline__ void gemm_phase(PG8_LAS unsigned char* lds, const Gemm g, const Sched& S, const Epi& E) {
    const int tid = threadIdx.x, wid = __builtin_amdgcn_readfirstlane(tid >> 6), lane = tid & 63, wr = wid >> 2, wc = wid & 3, fr = lane & 15, fq = lane >> 4;
    const int K = g.K, nt = K / BK;
    unsigned voffA[2], voffB[2];
#pragma unroll
    for (int i = 0; i < 2; ++i) { int R, C; stage_rc(tid * 16 + i * 8192, R, C); const int Rb = Epi::PERM ? ((R & ~31) + perm32(R & 31)) : R;
        voffA[i] = (unsigned)(R * K + C) * 2u; voffB[i] = (unsigned)(Rb * K + C) * 2u; }
    const size_t kstep = (size_t)(BK * 2);
    const size_t hstep = (size_t)HALF * K * 2;
    const size_t tstep = 2 * hstep;
    const unsigned ldsw = (unsigned)wid * 1024u;
    const int aoff = lds_byte(wr * 64 + fr, fq * 8), boff = lds_byte(wc * 32 + fr, fq * 8);
#define PG8_SA(b, h) (((b) * 2 + (h)) * HTB)
#define PG8_SB(b, h) ((4 + (b) * 2 + (h)) * HTB)
#define PG8_STAGE(bufoff, gbase, voff) do { _Pragma("unroll") for (int _i = 0; _i < 2; ++_i) \
        __builtin_amdgcn_global_load_lds((const unsigned*)((const char*)(gbase) + (voff)[_i]), (PG8_LAS unsigned*)(lds + (bufoff) + ldsw + _i * 8192), 16, 0, 0); } while (0)
#define PG8_LDA(dst, b, h) do { _Pragma("unroll") for (int m = 0; m < 4; ++m) _Pragma("unroll") for (int k = 0; k < 2; ++k) dst[m][k] = *(const PG8_LAS bf16x8*)(lds + PG8_SA(b, h) + aoff + m * 2048 + k * 1024); } while (0)
#define PG8_LDB(dst, b, h) do { _Pragma("unroll") for (int n = 0; n < 2; ++n) _Pragma("unroll") for (int k = 0; k < 2; ++k) dst[n][k] = *(const PG8_LAS bf16x8*)(lds + PG8_SB(b, h) + boff + n * 2048 + k * 1024); } while (0)
#define PG8_MMA(ai, bj, At, Bt) do { __builtin_amdgcn_s_setprio(1); _Pragma("unroll") for (int m = 0; m < 4; ++m) _Pragma("unroll") for (int n = 0; n < 2; ++n) _Pragma("unroll") for (int k = 0; k < 2; ++k) \
        acc[ai][bj][m][n] = __builtin_amdgcn_mfma_f32_16x16x32_bf16(Bt[n][k], At[m][k], acc[ai][bj][m][n], 0, 0, 0); __builtin_amdgcn_s_setprio(0); } while (0)
#define PG8_WAIT_V(n) asm volatile("s_waitcnt vmcnt(" #n ")" ::: "memory")
#define PG8_WAIT_L(n) asm volatile("s_waitcnt lgkmcnt(" #n ")" ::: "memory")
#define PG8_BAR __builtin_amdgcn_s_barrier()
#define PG8_SCHED __builtin_amdgcn_sched_barrier(0)
    Unit cur, nxt; int ui = 0;
    if (!S.next(0, cur)) return;
    f32x4 acc[2][2][4][2];
#pragma unroll
    for (int a = 0; a < 2; ++a)
#pragma unroll
        for (int b = 0; b < 2; ++b)
#pragma unroll
            for (int m = 0; m < 4; ++m)
#pragma unroll
                for (int n = 0; n < 2; ++n) acc[a][b][m][n] = (f32x4){0.f, 0.f, 0.f, 0.f};
    bf16x8 At[4][2], B0[2][2], B1[2][2];
    const char* cA = (const char*)g.A + (size_t)cur.pm * tstep; const char* cB = (const char*)g.Bt + (size_t)cur.pn * tstep;
    S.a_ready(cur);
    if constexpr (SP2) {
        PG8_STAGE(PG8_SB(0, 0), cB, voffB); PG8_STAGE(PG8_SB(0, 1), cB + hstep, voffB); PG8_STAGE(PG8_SA(0, 0), cA, voffA); PG8_STAGE(PG8_SA(0, 1), cA + hstep, voffA);
        if (wr == 1) PG8_BAR;
        PG8_WAIT_V(2); PG8_BAR;
        PG8_STAGE(PG8_SB(1, 0), cB + kstep, voffB); PG8_STAGE(PG8_SA(1, 0), cA + kstep, voffA); PG8_STAGE(PG8_SB(1, 1), cB + hstep + kstep, voffB);
        PG8_WAIT_V(6); PG8_BAR;
    } else {
        PG8_STAGE(PG8_SB(0, 0), cB, voffB); PG8_STAGE(PG8_SA(0, 0), cA, voffA); PG8_STAGE(PG8_SB(0, 1), cB + hstep, voffB); PG8_STAGE(PG8_SA(0, 1), cA + hstep, voffA);
        if (wr == 1) PG8_BAR;
        PG8_WAIT_V(4); PG8_BAR;
        PG8_STAGE(PG8_SB(1, 0), cB + kstep, voffB); PG8_STAGE(PG8_SA(1, 0), cA + kstep, voffA); PG8_STAGE(PG8_SB(1, 1), cB + hstep + kstep, voffB);
        PG8_WAIT_V(6); PG8_BAR;
    }
    for (;;) {
        const bool has_next = S.next(ui + 1, nxt);
        const char* nA = has_next ? (const char*)g.A + (size_t)nxt.pm * tstep : cA; const char* nB = has_next ? (const char*)g.Bt + (size_t)nxt.pn * tstep : cB;
        for (int t = 0; t < nt; t += 2) {
            const bool last = (t == nt - 2);
            const char* a1 = cA + (size_t)(t + 1) * kstep;
            const char* a2 = last ? nA : cA + (size_t)(t + 2) * kstep; const char* b2 = last ? nB : cB + (size_t)(t + 2) * kstep;
            const char* a3 = a2 + kstep; const char* b3 = b2 + kstep;
            if (last && has_next) S.a_ready(nxt);
            if constexpr (SP2) {
            PG8_LDB(B0, 0, 0); PG8_LDB(B1, 0, 1); PG8_SCHED; PG8_LDA(At, 0, 0); PG8_STAGE(PG8_SA(1, 1), a1 + hstep, voffA);
            PG8_WAIT_V(8); PG8_WAIT_L(0); PG8_BAR; PG8_MMA(0, 0, At, B0); PG8_MMA(0, 1, At, B1); PG8_BAR; PG8_SCHED;
            PG8_LDA(At, 0, 1); PG8_STAGE(PG8_SB(0, 0), b2, voffB); PG8_STAGE(PG8_SB(0, 1), b2 + hstep, voffB); PG8_STAGE(PG8_SA(0, 0), a2, voffA);
            PG8_WAIT_V(8); PG8_WAIT_L(0); PG8_BAR; PG8_MMA(1, 0, At, B0); PG8_MMA(1, 1, At, B1); PG8_BAR; PG8_SCHED;
            PG8_LDB(B0, 1, 0); PG8_LDB(B1, 1, 1); PG8_SCHED; PG8_LDA(At, 1, 0); PG8_STAGE(PG8_SA(0, 1), a2 + hstep, voffA);
            PG8_WAIT_V(8); PG8_WAIT_L(0); PG8_BAR; PG8_MMA(0, 0, At, B0); PG8_MMA(0, 1, At, B1); PG8_BAR; PG8_SCHED;
            PG8_LDA(At, 1, 1); PG8_STAGE(PG8_SB(1, 0), b3, voffB); PG8_STAGE(PG8_SB(1, 1), b3 + hstep, voffB); PG8_STAGE(PG8_SA(1, 0), a3, voffA);
            PG8_WAIT_V(8); PG8_WAIT_L(0); PG8_BAR; PG8_MMA(1, 0, At, B0); PG8_MMA(1, 1, At, B1); PG8_BAR; PG8_SCHED;
            } else {
            PG8_LDB(B0, 0, 0); PG8_SCHED; PG8_LDA(At, 0, 0); PG8_STAGE(PG8_SA(1, 1), a1 + hstep, voffA);
            PG8_WAIT_L(8); PG8_BAR; PG8_WAIT_L(0); PG8_MMA(0, 0, At, B0); PG8_BAR; PG8_SCHED;
            PG8_LDB(B1, 0, 1); PG8_STAGE(PG8_SB(0, 0), b2, voffB);
            PG8_BAR; PG8_WAIT_L(0); PG8_MMA(0, 1, At, B1); PG8_BAR;
            PG8_LDA(At, 0, 1); PG8_STAGE(PG8_SA(0, 0), a2, voffA);
            PG8_BAR; PG8_WAIT_L(0); PG8_MMA(1, 0, At, B0); PG8_BAR; PG8_SCHED;
            PG8_STAGE(PG8_SB(0, 1), b2 + hstep, voffB);
            PG8_WAIT_V(6); PG8_BAR; PG8_MMA(1, 1, At, B1); PG8_BAR;
            PG8_LDB(B0, 1, 0); PG8_SCHED; PG8_LDA(At, 1, 0); PG8_STAGE(PG8_SA(0, 1), a2 + hstep, voffA);
            PG8_WAIT_L(8); PG8_BAR; PG8_WAIT_L(0); PG8_MMA(0, 0, At, B0); PG8_BAR; PG8_SCHED;
            PG8_LDB(B1, 1, 1); PG8_STAGE(PG8_SB(1, 0), b3, voffB);
            PG8_BAR; PG8_WAIT_L(0); PG8_MMA(0, 1, At, B1); PG8_BAR;
            PG8_LDA(At, 1, 1); PG8_STAGE(PG8_SA(1, 0), a3, voffA);
            PG8_BAR; PG8_WAIT_L(0); PG8_MMA(1, 0, At, B0); PG8_BAR; PG8_SCHED;
            PG8_STAGE(PG8_SB(1, 1), b3 + hstep, voffB);
            PG8_WAIT_V(6); PG8_BAR; PG8_MMA(1, 1, At, B1); PG8_BAR;
            }
        }
        if constexpr (ALIGN_EPI) { if (wr == 0) PG8_BAR; }
        if constexpr (!Epi::AFTER_DRAIN) { E(acc, cur, wr, wc, fr, fq); S.done(cur); }
        if (!has_next) break;
#pragma unroll
        for (int a = 0; a < 2; ++a)
#pragma unroll
            for (int b = 0; b < 2; ++b)
#pragma unroll
                for (int m = 0; m < 4; ++m)
#pragma unroll
                    for (int n = 0; n < 2; ++n) acc[a][b][m][n] = (f32x4){0.f, 0.f, 0.f, 0.f};
        cur = nxt; cA = nA; cB = nB; ++ui;
        if constexpr (ALIGN_EPI) { if (wr == 1) PG8_BAR; }
    }
    PG8_WAIT_V(0);
    if constexpr (!ALIGN_EPI) { if (wr == 0) PG8_BAR; }
    PG8_BAR;
    if constexpr (Epi::AFTER_DRAIN) { E.fused(acc, cur, wr, wc, fr, fq, lds, wid, lane); S.done(cur); }
#undef PG8_SA
#undef PG8_SB
#undef PG8_STAGE
#undef PG8_LDA
#undef PG8_LDB
#undef PG8_MMA
#undef PG8_WAIT_V
#undef PG8_WAIT_L
#undef PG8_BAR
#undef PG8_SCHED
}
}
typedef unsigned short bf16;
constexpr int S_ = 8192, DM = 2048, DIN = 6656, DF = 512, DD = 1024, DG = 512, NH = 8, DEPTH = 2;
constexpr int OFF_AIN = 0, OFF_AG = 512, OFF_Q = 1024, OFF_K = 2048, OFF_V = 3072, OFF_BG = 4096, OFF_U = 5120, OFF_VS = 5632, OFF_CG = 6144;
constexpr float EPS = 1e-6f;
constexpr float LAMBDA_INIT0 = 0.2f;
constexpr float LAMBDA_INIT1 = 0.35550906759f;
__host__ __device__ __forceinline__ float lambda_init(int l) { return l == 0 ? LAMBDA_INIT0 : LAMBDA_INIT1; }

__device__ __forceinline__ unsigned f2bf(float f) { unsigned u = __builtin_bit_cast(unsigned, f); return (u + 0x7fffu + ((u >> 16) & 1u)) >> 16; }
__device__ __forceinline__ float bf2f(unsigned short b) { return __builtin_bit_cast(float, (unsigned)b << 16); }
__device__ __forceinline__ float wave_sum(float v) {
#pragma unroll
    for (int o = 1; o < 64; o <<= 1) v += __shfl_xor(v, o);
    return v;
}
__device__ __forceinline__ float wave_max(float v) {
#pragma unroll
    for (int o = 1; o < 64; o <<= 1) v = fmaxf(v, __shfl_xor(v, o));
    return v;
}
__device__ __forceinline__ float silu(float x) { return x / (1.f + __expf(-x)); }

constexpr size_t MiB = 1u << 20;
constexpr size_t WS_CTL = 0;
constexpr size_t WS_TAB = 64 * 1024;
constexpr size_t WS_BIAS = 192 * 1024;
constexpr size_t WS_LAM = 256 * 1024;
constexpr size_t WS_RSTDSG = 512 * 1024;
constexpr size_t WS_WINT = 1 * MiB;
constexpr size_t WS_WOUTT = 54 * MiB;
constexpr size_t WS_WF2T = 70 * MiB;
constexpr size_t WS_XN = 72 * MiB;
constexpr size_t WS_PROJ = 104 * MiB;
constexpr size_t WS_TP = 208 * MiB;
constexpr size_t WS_X2 = 224 * MiB;
constexpr size_t WS_Y = 240 * MiB;
constexpr size_t WS_YOUT = 272 * MiB;
constexpr size_t WS_END = 336 * MiB;

#define LAS __attribute__((address_space(3)))
#define GAS __attribute__((address_space(1)))
typedef unsigned v4u __attribute__((ext_vector_type(4)));
constexpr int NTHR = 512, NWAVES = 8;
constexpr int LDS_BYTES = 147456;
#define LDS_WAIT() asm volatile("s_waitcnt lgkmcnt(0)" ::: "memory")
__device__ __forceinline__ unsigned pk2(float lo, float hi) { return f2bf(lo) | (f2bf(hi) << 16); }

__device__ __forceinline__ void p0_transpose_item(const float* W, int K, int N, bf16* WT, LAS float* scr, int item, int lane) {
    const int nblk = N / 32, kb = item / nblk, nb = item % nblk, k0 = 64 * kb, n0 = 32 * nb;
#pragma unroll 8
    for (int i = 0; i < 32; ++i) { const int kk = 2 * i + (lane >> 5); scr[kk * 33 + (lane & 31)] = W[(size_t)(k0 + kk) * N + n0 + (lane & 31)]; }
    LDS_WAIT(); asm volatile("" ::: "memory");
    const int c = lane & 7;
#pragma unroll
    for (int j = 0; j < 4; ++j) { const int n = (lane >> 3) + 8 * j; const LAS float* s = scr + (8 * c) * 33 + n;
        v4u o; o.x = pk2(s[0 * 33], s[1 * 33]); o.y = pk2(s[2 * 33], s[3 * 33]); o.z = pk2(s[4 * 33], s[5 * 33]); o.w = pk2(s[6 * 33], s[7 * 33]);
        *(v4u*)(WT + (size_t)(n0 + n) * K + k0 + 8 * c) = o; }
    LDS_WAIT(); asm volatile("" ::: "memory");
}
__device__ __forceinline__ void rms_row_to_bf16(const float4 (&v)[8], const float* gain, bf16* xnrow, int lane) {
    float ss = 0.f;
#pragma unroll
    for (int j = 0; j < 8; ++j) ss += v[j].x * v[j].x + v[j].y * v[j].y + v[j].z * v[j].z + v[j].w * v[j].w;
    const float rstd = rsqrtf(wave_sum(ss) * (1.f / DM) + EPS);
    const float4* gr = (const float4*)gain + lane; uint2* o = (uint2*)xnrow + lane;
#pragma unroll
    for (int j = 0; j < 8; ++j) { const float4 g = gr[64 * j];
        o[64 * j] = make_uint2(pk2(v[j].x * rstd * g.x, v[j].y * rstd * g.y), pk2(v[j].z * rstd * g.z, v[j].w * rstd * g.w)); }
}
#define GTID ((int)(blockIdx.x * NTHR + threadIdx.x))
#define GSIZE ((int)(gridDim.x * NTHR))
#define GWAVE ((int)(blockIdx.x * NWAVES + (threadIdx.x >> 6)))
#define GNWAVES ((int)(gridDim.x * NWAVES))
__device__ __forceinline__ int t5_bucket(int rel) {
    const int ret = rel > 0 ? 16 : 0; const int n = rel < 0 ? -rel : rel;
    if (n < 8) return ret + n;
    int j = 0; while (j < 7 && (64 << (j + 1)) <= n * n) ++j;
    return ret + 8 + j;
}
__device__ __forceinline__ void ph_wf2(const float* __restrict__ wf, bf16* __restrict__ Wf2T) {
    for (int idx = GTID; idx < 512 * 1024; idx += GSIZE) {
        const int j = idx >> 10, pc = idx & 1023, part = pc >> 9, c = pc & 511, g = c >> 7, n3 = c & 127;
        float acc = 0.f;
        for (int k3 = 0; k3 < 128; ++k3) { const int a = (k3 * n3) & 127; float sn, cs; sincospif((float)a * (1.f / 64.f), &sn, &cs);
            acc += (part ? sn : cs) * wf[(size_t)(g * 128 + k3) * 512 + j]; }
        Wf2T[idx] = (bf16)f2bf(acc * 9.765625e-4f); }
}
__device__ __forceinline__ void ph_tables(const float* __restrict__ rel_bias, const float* __restrict__ lambda_qk, float2* __restrict__ trig, float* __restrict__ biasTab, float* __restrict__ lam) {
    for (int idx = GTID; idx < 8192; idx += GSIZE) {
        { float sn, cs; sincospif((float)idx * (1.f / 4096.f), &sn, &cs); trig[idx] = make_float2(cs, sn); }
        if (idx < 8 * 272) { const int h = idx / 272, i = idx % 272; int rel = i - 128; if (rel > 128) rel = 128; biasTab[idx] = rel_bias[t5_bucket(rel) * 8 + h]; }
        if (idx < 2) { const float* lq = lambda_qk + idx * 256; float a = 0.f, b = 0.f; for (int i = 0; i < 64; ++i) { a += lq[i] * lq[64 + i]; b += lq[128 + i] * lq[192 + i]; }
            lam[idx] = expf(a) - expf(b) + lambda_init(idx); } }
}
__device__ __forceinline__ void ph_f1_naive(const bf16* __restrict__ proj, const float2* __restrict__ trig, bf16* __restrict__ Tp) {
    for (int idx = GTID; idx < 128 * 64 * 512; idx += GSIZE) { const int c = idx & 511, n2 = (idx >> 9) & 63, k1 = idx >> 15;
        float tr = 0.f, ti = 0.f;
        for (int n1 = 0; n1 < 128; ++n1) { const float a = bf2f(proj[(size_t)(64 * n1 + n2) * DIN + OFF_AIN + c]); const float2 cs = trig[((n1 * k1) & 127) * 64]; tr += a * cs.x; ti -= a * cs.y; }
        const float2 tw = trig[k1 * n2];
        const float pr = tr * tw.x + ti * tw.y, pi = ti * tw.x - tr * tw.y;
        Tp[((size_t)(k1 * 64 + n2) * 2 + 0) * 512 + c] = (bf16)f2bf(pr); Tp[((size_t)(k1 * 64 + n2) * 2 + 1) * 512 + c] = (bf16)f2bf(pi); }
}
__device__ __forceinline__ void ph_f2_naive(const bf16* __restrict__ Tp, const float2* __restrict__ trig, bf16* __restrict__ X2) {
    for (int idx = GTID; idx < 128 * 64 * 512; idx += GSIZE) { const int c = idx & 511, k2 = (idx >> 9) & 63, k1 = idx >> 15;
        float xr = 0.f, xi = 0.f;
        for (int n2 = 0; n2 < 64; ++n2) { const float tr = bf2f(Tp[((size_t)(k1 * 64 + n2) * 2 + 0) * 512 + c]), ti = bf2f(Tp[((size_t)(k1 * 64 + n2) * 2 + 1) * 512 + c]);
            const float2 cs = trig[((n2 * k2) & 63) * 128]; xr += tr * cs.x + ti * cs.y; xi += ti * cs.x - tr * cs.y; }
        X2[(size_t)(k1 * 64 + k2) * 1024 + c] = (bf16)f2bf(xr); X2[(size_t)(k1 * 64 + k2) * 1024 + 512 + c] = (bf16)f2bf(xi); }
}
__device__ __forceinline__ void ph_ya_naive(const bf16* __restrict__ X2, const bf16* __restrict__ Wf2T, const bf16* __restrict__ proj, bf16* __restrict__ Y) {
    for (int idx = GTID; idx < 8192 * 512; idx += GSIZE) { const int j = idx & 511, rho = idx >> 9, k1 = rho >> 6, k2 = rho & 63, row = k1 + 128 * k2;
        float acc = 0.f;
        for (int pc = 0; pc < 1024; ++pc) acc += bf2f(X2[(size_t)rho * 1024 + pc]) * bf2f(Wf2T[(size_t)j * 1024 + pc]);
        Y[(size_t)row * DM + j] = (bf16)f2bf(acc * silu(bf2f(proj[(size_t)row * DIN + OFF_AG + j]))); }
}
__device__ __forceinline__ void ph_sgu_rstd(const bf16* __restrict__ proj, float* __restrict__ rstd_sg) {
    for (int idx = GTID; idx < 8192 * 4; idx += GSIZE) { const int g = idx & 3, pos = idx >> 2;
        float ss = 0.f; for (int c = 0; c < 128; ++c) { const float v = bf2f(proj[(size_t)pos * DIN + OFF_VS + g * 128 + c]); ss += v * v; }
        rstd_sg[idx] = rsqrtf(ss * (1.f / 128.f) + EPS); }
}
__device__ __forceinline__ void ph_sgu_naive(const bf16* __restrict__ proj, const float* __restrict__ rstd_sg, const float* __restrict__ vgain, const float* __restrict__ ws, const float* __restrict__ bs, bf16* __restrict__ Y) {
    for (int idx = GTID; idx < 8192 * 512; idx += GSIZE) { const int gc = idx & 511, p = idx >> 9, g = gc >> 7, pp = p & 127, ch = p >> 7;
        float acc = 0.f; const float gn = vgain[gc];
        for (int q = 0; q < 128; ++q) { const int pos = ch * 128 + q; acc += ws[(size_t)(g * 128 + pp) * 128 + q] * (bf2f(proj[(size_t)pos * DIN + OFF_VS + gc]) * rstd_sg[pos * 4 + g] * gn); }
        const float mixed = acc + bs[g * 128 + pp];
        const float u = bf2f(proj[(size_t)p * DIN + OFF_U + gc]);
        Y[(size_t)p * DM + 1536 + gc] = (bf16)f2bf(u * mixed * silu(bf2f(proj[(size_t)p * DIN + OFF_CG + gc]))); }
}
__device__ __forceinline__ void ph_attn_naive(const bf16* __restrict__ proj, const float* __restrict__ biasTab, const float* __restrict__ lamp, const float* __restrict__ ogain, int layer, bf16* __restrict__ Y) {
  const int lane = threadIdx.x & 63;
  for (int w = GWAVE; w < NH * S_; w += GNWAVES) { const int h = w >> 13, q = w & 8191;
    float qv[128];
    { const bf16* qp = proj + (size_t)q * DIN + OFF_Q + h * 128;
#pragma unroll
      for (int d = 0; d < 128; ++d) qv[d] = bf2f(qp[d]) * 0.125f; }
    const float* bt = biasTab + h * 272 + 128;
    float m0 = -1e30f, m1 = -1e30f, l0 = 0.f, l1 = 0.f;
    for (int t = 0; t < 128; ++t) { const int k = t * 64 + lane; const uint4* kp = (const uint4*)(proj + (size_t)k * DIN + OFF_K + h * 128);
        float s0 = 0.f, s1 = 0.f;
#pragma unroll
        for (int i = 0; i < 16; ++i) { const uint4 kk = kp[i]; const unsigned wv[4] = {kk.x, kk.y, kk.z, kk.w};
#pragma unroll
            for (int e = 0; e < 4; ++e) { const float a = __builtin_bit_cast(float, wv[e] << 16), b = __builtin_bit_cast(float, wv[e] & 0xffff0000u);
                if (i < 8) s0 += qv[i * 8 + e * 2] * a + qv[i * 8 + e * 2 + 1] * b; else s1 += qv[i * 8 + e * 2] * a + qv[i * 8 + e * 2 + 1] * b; } }
        int rel = k - q; rel = rel < -128 ? -128 : (rel > 128 ? 128 : rel); const float b = bt[rel]; s0 += b; s1 += b;
        { const float mn = fmaxf(m0, s0); l0 = l0 * __expf(m0 - mn) + __expf(s0 - mn); m0 = mn; }
        { const float mn = fmaxf(m1, s1); l1 = l1 * __expf(m1 - mn) + __expf(s1 - mn); m1 = mn; } }
    { const float M0 = wave_max(m0), M1 = wave_max(m1); l0 = wave_sum(l0 * __expf(m0 - M0)); l1 = wave_sum(l1 * __expf(m1 - M1)); m0 = M0; m1 = M1; }
    const float lam = lamp[layer], il0 = 1.f / l0, il1 = lam / l1;
    float acc0 = 0.f, acc1 = 0.f;
    for (int t = 0; t < 128; ++t) { const int k = t * 64 + lane; const uint4* kp = (const uint4*)(proj + (size_t)k * DIN + OFF_K + h * 128);
        float s0 = 0.f, s1 = 0.f;
#pragma unroll
        for (int i = 0; i < 16; ++i) { const uint4 kk = kp[i]; const unsigned wv[4] = {kk.x, kk.y, kk.z, kk.w};
#pragma unroll
            for (int e = 0; e < 4; ++e) { const float a = __builtin_bit_cast(float, wv[e] << 16), b = __builtin_bit_cast(float, wv[e] & 0xffff0000u);
                if (i < 8) s0 += qv[i * 8 + e * 2] * a + qv[i * 8 + e * 2 + 1] * b; else s1 += qv[i * 8 + e * 2] * a + qv[i * 8 + e * 2 + 1] * b; } }
        int rel = k - q; rel = rel < -128 ? -128 : (rel > 128 ? 128 : rel); const float b = bt[rel]; s0 += b; s1 += b;
        const float wgt = __expf(s0 - m0) * il0 - __expf(s1 - m1) * il1;
        const unsigned* vp = (const unsigned*)(proj + (size_t)(t * 64) * DIN + OFF_V + h * 128) + lane;
        for (int kk = 0; kk < 64; ++kk) { const float wk = __shfl(wgt, kk); const unsigned vv = vp[(size_t)kk * (DIN / 2)];
            acc0 += wk * __builtin_bit_cast(float, vv << 16); acc1 += wk * __builtin_bit_cast(float, vv & 0xffff0000u); } }
    const float rstd = rsqrtf(wave_sum(acc0 * acc0 + acc1 * acc1) * (1.f / 128.f) + EPS) * (1.f - lambda_init(layer));
    const int col = h * 128 + 2 * lane;
    const float y0 = acc0 * rstd * ogain[col] * silu(bf2f(proj[(size_t)q * DIN + OFF_BG + col]));
    const float y1 = acc1 * rstd * ogain[col + 1] * silu(bf2f(proj[(size_t)q * DIN + OFF_BG + col + 1]));
    *(unsigned*)(Y + (size_t)q * DM + 512 + col) = f2bf(y0) | (f2bf(y1) << 16);
  }
}
#include <hip/hip_cooperative_groups.h>
namespace cg = cooperative_groups;
struct Args { const float* in[12]; float* out; unsigned char* ws; };
#define GRID_SYNC() grid.sync()
__global__ void __launch_bounds__(NTHR, 2) mega_fwd(Args a) {
    extern __shared__ __attribute__((aligned(16))) unsigned char lds[];
    cg::grid_group grid = cg::this_grid();
    const int tid = threadIdx.x, lane = tid & 63, wave = __builtin_amdgcn_readfirstlane(tid >> 6);
    const int gw = (int)blockIdx.x * NWAVES + wave, NGW = (int)gridDim.x * NWAVES;
    const float* x = a.in[0]; const float* w_in = a.in[1]; const float* pre_gain = a.in[2]; const float* post_gain = a.in[3];
    const float* w_fourier = a.in[4]; const float* lambda_qk = a.in[5]; const float* diff_out_gain = a.in[6]; const float* sg_v_gain = a.in[7];
    const float* w_spatial = a.in[8]; const float* b_spatial = a.in[9]; const float* w_out = a.in[10]; const float* rel_bias = a.in[11];
    unsigned char* ws = a.ws; float* out = a.out;
    float2* trig = (float2*)(ws + WS_TAB); float* biasTab = (float*)(ws + WS_BIAS); float* lam = (float*)(ws + WS_LAM); float* rstd_sg = (float*)(ws + WS_RSTDSG);
    bf16* WinT = (bf16*)(ws + WS_WINT); bf16* WoutT = (bf16*)(ws + WS_WOUTT); bf16* Wf2T = (bf16*)(ws + WS_WF2T); bf16* XN = (bf16*)(ws + WS_XN); bf16* PROJ = (bf16*)(ws + WS_PROJ);
    bf16* TP = (bf16*)(ws + WS_TP); bf16* X2 = (bf16*)(ws + WS_X2); bf16* Y = (bf16*)(ws + WS_Y); float* YOUT = (float*)(ws + WS_YOUT);
    LAS unsigned char* L = (LAS unsigned char*)lds;

    {
        LAS float* scr = (LAS float*)(L + wave * 16384);
        constexpr int I_IN = (DM / 64) * (DIN / 32), I_OUT = (DM / 64) * (DM / 32), I_L = I_IN + I_OUT;
        for (int it = gw; it < DEPTH * I_L; it += NGW) { const int l = it / I_L, r = it % I_L;
            if (r < I_IN) p0_transpose_item(w_in + (size_t)l * DM * DIN, DM, DIN, WinT + (size_t)l * DIN * DM, scr, r, lane);
            else p0_transpose_item(w_out + (size_t)l * DM * DM, DM, DM, WoutT + (size_t)l * DM * DM, scr, r - I_IN, lane); }
        ph_wf2(w_fourier, Wf2T); ph_wf2(w_fourier + (size_t)DF * DF, Wf2T + (size_t)512 * 1024);
        ph_tables(rel_bias, lambda_qk, trig, biasTab, lam);
        for (int row = gw; row < S_; row += NGW) { const float4* xr = (const float4*)(x + (size_t)row * DM) + lane; float4 v[8];
#pragma unroll
            for (int j = 0; j < 8; ++j) v[j] = xr[64 * j];
            rms_row_to_bf16(v, pre_gain, XN + (size_t)row * DM, lane); }
    }
    GRID_SYNC();
#pragma unroll
    for (int l = 0; l < DEPTH; ++l) {
        const float* xsrc = l == 0 ? x : out;
        { pg8::Gemm g{XN, WinT + (size_t)l * DIN * DM, S_, DIN, DM}; pg8::StaticOrder S; S.init(S_, DIN, (int)gridDim.x, (int)blockIdx.x);
          pg8::EpiBf16 E{PROJ, DIN};
          pg8::gemm_phase<pg8::EpiBf16, pg8::StaticOrder, true, true>(L, g, S, E); }
        GRID_SYNC();
        ph_f1_naive(PROJ, trig, TP); ph_sgu_rstd(PROJ, rstd_sg);
        GRID_SYNC();
        ph_f2_naive(TP, trig, X2);
        ph_sgu_naive(PROJ, rstd_sg, sg_v_gain + l * DG, w_spatial + (size_t)l * 4 * 128 * 128, b_spatial + l * 4 * 128, Y);
        ph_attn_naive(PROJ, biasTab, lam, diff_out_gain + l * DD, l, Y);
        GRID_SYNC();
        ph_ya_naive(X2, Wf2T + (size_t)l * 512 * 1024, PROJ, Y);
        GRID_SYNC();
        { pg8::Gemm g{Y, WoutT + (size_t)l * DM * DM, S_, DM, DM}; pg8::StaticOrder S; S.init(S_, DM, (int)gridDim.x, (int)blockIdx.x);
          pg8::EpiF32 E{YOUT, DM};
          pg8::gemm_phase<pg8::EpiF32, pg8::StaticOrder, true, true>(L, g, S, E); }
        GRID_SYNC();
        for (int row = gw; row < S_; row += NGW) {
            const float4* yr = (const float4*)(YOUT + (size_t)row * DM) + lane; const float4* gr = (const float4*)(post_gain + l * DM) + lane; const float4* xr = (const float4*)(xsrc + (size_t)row * DM) + lane;
            float4 v[8]; float ss = 0.f;
#pragma unroll
            for (int j = 0; j < 8; ++j) { v[j] = yr[64 * j]; ss += v[j].x * v[j].x + v[j].y * v[j].y + v[j].z * v[j].z + v[j].w * v[j].w; }
            const float rstd = rsqrtf(wave_sum(ss) * (1.f / DM) + EPS);
            float4* o = (float4*)(out + (size_t)row * DM) + lane;
#pragma unroll
            for (int j = 0; j < 8; ++j) { const float4 g = gr[64 * j]; const float4 xv = xr[64 * j];
                v[j] = make_float4(xv.x + v[j].x * rstd * g.x, xv.y + v[j].y * rstd * g.y, xv.z + v[j].z * rstd * g.z, xv.w + v[j].w * rstd * g.w); o[64 * j] = v[j]; }
            if (l + 1 < DEPTH) rms_row_to_bf16(v, pre_gain + (l + 1) * DM, XN + (size_t)row * DM, lane);
        }
        if (l + 1 < DEPTH) GRID_SYNC();
    }
}

extern "C" void kernel_launch(void* const* d_in, const int* in_sizes, int n_in, void* d_out, int out_size, void* d_ws, size_t ws_size, hipStream_t stream) {
    static int grid = 0;
    if (grid == 0) {
        if (n_in != 12 || ws_size < WS_END) { fprintf(stderr, "kernel_launch: unexpected n_in %d / ws %zu\n", n_in, ws_size); grid = -1; return; }
        int dev = 0, cus = 0, per_cu = 0;
        if (hipGetDevice(&dev) != hipSuccess || hipDeviceGetAttribute(&cus, hipDeviceAttributeMultiprocessorCount, dev) != hipSuccess) { grid = -1; return; }
        if (hipFuncSetAttribute((const void*)mega_fwd, hipFuncAttributeMaxDynamicSharedMemorySize, LDS_BYTES) != hipSuccess) { fprintf(stderr, "kernel_launch: hipFuncSetAttribute failed\n"); grid = -1; return; }
        if (hipOccupancyMaxActiveBlocksPerMultiprocessor(&per_cu, (const void*)mega_fwd, NTHR, LDS_BYTES) != hipSuccess || per_cu < 1) { fprintf(stderr, "kernel_launch: occupancy query failed (%d)\n", per_cu); (void)hipGetLastError(); grid = -1; return; }
        grid = cus * per_cu;
    }
    if (grid < 0) return;
    Args a{};
    for (int i = 0; i < 12; ++i) a.in[i] = (const float*)d_in[i];
    a.out = (float*)d_out; a.ws = (unsigned char*)d_ws;
    void* args[] = {&a};
    hipError_t e = hipLaunchCooperativeKernel((const void*)mega_fwd, dim3(grid), dim3(NTHR), args, LDS_BYTES, stream);
    if (e != hipSuccess) fprintf(stderr, "cooperative launch failed: %s (grid %d)\n", hipGetErrorString(e), grid);
}
```

```cpp
#include <hip/hip_runtime.h>
#include <cstdio>
#include <cstdint>
__device__ __forceinline__ int fresh_tid() { int t = (int)threadIdx.x; asm volatile("" : "+v"(t)); return t; }
namespace pg8 {
#define PG8_LAS __attribute__((address_space(3)))
typedef unsigned short bf16_t;
typedef short bf16x8 __attribute__((ext_vector_type(8)));
typedef float f32x4 __attribute__((ext_vector_type(4)));
typedef unsigned u32x4 __attribute__((ext_vector_type(4)));
constexpr int BM = 256, BK = 64, HALF = 128, HTB = HALF * BK * 2  , STAGE_BYTES = 8 * HTB, NXCD = 8, WGM = 8;

__host__ __device__ __forceinline__ int lds_byte(int r, int c) { const int st = (r >> 4) * 2 + (c >> 5), rr = r & 15, cc = c & 31, ob = rr * 64 + cc * 2; return st * 1024 + (ob ^ (((ob >> 9) & 1) << 5)); }
__host__ __device__ __forceinline__ void stage_rc(int b, int& R, int& C) { const int st = b / 1024, sb = b % 1024, swz = sb ^ (((sb >> 9) & 1) << 5); R = (st >> 1) * 16 + swz / 64; C = (st & 1) * 32 + (swz % 64) / 2; }
__host__ __device__ __forceinline__ int perm32(int rho) { const int n = rho >> 4, i = rho & 15; return 8 * (i >> 2) + 4 * n + (i & 3); }

struct Unit { int pm, pn; };
struct Gemm { const bf16_t* A; const bf16_t* Bt; int M, N, K; };

struct StaticOrder {
    int nM, nN, nwg, G, c;
    __host__ __device__ void init(int M, int N, int G_, int c_) { nM = M / BM; nN = N / BM; nwg = nM * nN; G = G_; c = c_; }
    __host__ __device__ bool next(int i, Unit& u) const {
        const long L = (long)i * G + c; if (L >= nwg) return false;
        int wgid = (int)L; { const int q = nwg / NXCD, r = nwg % NXCD, xcd = wgid % NXCD, off = wgid / NXCD; wgid = (xcd < r ? xcd * (q + 1) : r * (q + 1) + (xcd - r) * q) + off; }
        const int nig = WGM * nN, gid = wgid / nig, fm = gid * WGM, gsz = (nM - fm) < WGM ? (nM - fm) : WGM;
        u.pm = fm + ((wgid % nig) % gsz); u.pn = (wgid % nig) / gsz; return true;
    }
    __device__ __forceinline__ void a_ready(const Unit&) const {}
    __device__ __forceinline__ void done(const Unit&) const {}
};

__device__ __forceinline__ unsigned cvt_pk_bf16(float lo, float hi) { unsigned r; asm volatile("v_cvt_pk_bf16_f32 %0, %1, %2" : "=v"(r) : "v"(lo), "v"(hi)); return r; }
struct EpiBf16 {
    static constexpr bool PERM = true, AFTER_DRAIN = false;
    bf16_t* O; int ldc;
    __device__ __forceinline__ void operator()(const f32x4 (&acc)[2][2][4][2], const Unit& u, int wr, int wc, int fr, int fq) const {
        const int row0 = u.pm * BM + wr * 64 + fr; const int col0 = u.pn * BM + wc * 32 + 8 * fq;
#pragma unroll
        for (int ai = 0; ai < 2; ++ai)
#pragma unroll
            for (int m = 0; m < 4; ++m) { bf16_t* rowp = O + (size_t)(row0 + ai * HALF + m * 16) * ldc + col0;
#pragma unroll
                for (int bj = 0; bj < 2; ++bj) { const f32x4 v0 = acc[ai][bj][m][0], v1 = acc[ai][bj][m][1];
                    u32x4 w; w.x = cvt_pk_bf16(v0[0], v0[1]); w.y = cvt_pk_bf16(v0[2], v0[3]); w.z = cvt_pk_bf16(v1[0], v1[1]); w.w = cvt_pk_bf16(v1[2], v1[3]);
                    *(u32x4*)(rowp + bj * HALF) = w; } }
    }
};
struct EpiF32 {
    static constexpr bool PERM = false, AFTER_DRAIN = false;
    float* C; int ldc;
    __device__ __forceinline__ void operator()(const f32x4 (&acc)[2][2][4][2], const Unit& u, int wr, int wc, int fr, int fq) const {
        const int row0 = u.pm * BM + wr * 64 + fr, col0 = u.pn * BM + wc * 32 + 4 * fq;
#pragma unroll
        for (int ai = 0; ai < 2; ++ai)
#pragma unroll
            for (int m = 0; m < 4; ++m) { float* rowp = C + (size_t)(row0 + ai * HALF + m * 16) * ldc + col0;
#pragma unroll
                for (int bj = 0; bj < 2; ++bj)
#pragma unroll
                    for (int n = 0; n < 2; ++n) *(f32x4*)(rowp + bj * HALF + n * 16) = acc[ai][bj][m][n]; }
    }
};
template <class Epi, class Sched, bool ALIGN_EPI = false, bool SP2 = false>
__device__ __forceinline__ void gemm_phase(PG8_LAS unsigned char* lds, const Gemm g, const Sched& S, const Epi& E) {
    const int tid = fresh_tid(), wid = __builtin_amdgcn_readfirstlane(tid >> 6), lane = tid & 63, wr = wid >> 2, wc = wid & 3, fr = lane & 15, fq = lane >> 4;
    const int K = g.K, nt = K / BK;
    unsigned voffA[2], voffB[2];
#pragma unroll
    for (int i = 0; i < 2; ++i) { int R, C; stage_rc(tid * 16 + i * 8192, R, C); const int Rb = Epi::PERM ? ((R & ~31) + perm32(R & 31)) : R;
        voffA[i] = (unsigned)(R * K + C) * 2u; voffB[i] = (unsigned)(Rb * K + C) * 2u; }
    const size_t kstep = (size_t)(BK * 2);
    const size_t hstep = (size_t)HALF * K * 2;
    const size_t tstep = 2 * hstep;
    const unsigned ldsw = (unsigned)wid * 1024u;
    const int aoff = lds_byte(wr * 64 + fr, fq * 8), boff = lds_byte(wc * 32 + fr, fq * 8);
#define PG8_SA(b, h) (((b) * 2 + (h)) * HTB)
#define PG8_SB(b, h) ((4 + (b) * 2 + (h)) * HTB)
#define PG8_STAGE(bufoff, gbase, voff) do { _Pragma("unroll") for (int _i = 0; _i < 2; ++_i) \
        __builtin_amdgcn_global_load_lds((const unsigned*)((const char*)(gbase) + (voff)[_i]), (PG8_LAS unsigned*)(lds + (bufoff) + ldsw + _i * 8192), 16, 0, 0); } while (0)
#define PG8_LDA(dst, b, h) do { _Pragma("unroll") for (int m = 0; m < 4; ++m) _Pragma("unroll") for (int k = 0; k < 2; ++k) dst[m][k] = *(const PG8_LAS bf16x8*)(lds + PG8_SA(b, h) + aoff + m * 2048 + k * 1024); } while (0)
#define PG8_LDB(dst, b, h) do { _Pragma("unroll") for (int n = 0; n < 2; ++n) _Pragma("unroll") for (int k = 0; k < 2; ++k) dst[n][k] = *(const PG8_LAS bf16x8*)(lds + PG8_SB(b, h) + boff + n * 2048 + k * 1024); } while (0)
#define PG8_MMA(ai, bj, At, Bt) do { __builtin_amdgcn_s_setprio(1); _Pragma("unroll") for (int m = 0; m < 4; ++m) _Pragma("unroll") for (int n = 0; n < 2; ++n) _Pragma("unroll") for (int k = 0; k < 2; ++k) \
        acc[ai][bj][m][n] = __builtin_amdgcn_mfma_f32_16x16x32_bf16(Bt[n][k], At[m][k], acc[ai][bj][m][n], 0, 0, 0); __builtin_amdgcn_s_setprio(0); } while (0)
#define PG8_WAIT_V(n) asm volatile("s_waitcnt vmcnt(" #n ")" ::: "memory")
#define PG8_WAIT_L(n) asm volatile("s_waitcnt lgkmcnt(" #n ")" ::: "memory")
#define PG8_BAR __builtin_amdgcn_s_barrier()
#define PG8_SCHED __builtin_amdgcn_sched_barrier(0)
    Unit cur, nxt; int ui = 0;
    if (!S.next(0, cur)) return;
    f32x4 acc[2][2][4][2];
#pragma unroll
    for (int a = 0; a < 2; ++a)
#pragma unroll
        for (int b = 0; b < 2; ++b)
#pragma unroll
            for (int m = 0; m < 4; ++m)
#pragma unroll
                for (int n = 0; n < 2; ++n) acc[a][b][m][n] = (f32x4){0.f, 0.f, 0.f, 0.f};
    bf16x8 At[4][2], B0[2][2], B1[2][2];
    const char* cA = (const char*)g.A + (size_t)cur.pm * tstep; const char* cB = (const char*)g.Bt + (size_t)cur.pn * tstep;
    S.a_ready(cur);
    if constexpr (SP2) {
        PG8_STAGE(PG8_SB(0, 0), cB, voffB); PG8_STAGE(PG8_SB(0, 1), cB + hstep, voffB); PG8_STAGE(PG8_SA(0, 0), cA, voffA); PG8_STAGE(PG8_SA(0, 1), cA + hstep, voffA);
        if (wr == 1) PG8_BAR;
        PG8_WAIT_V(2); PG8_BAR;
        PG8_STAGE(PG8_SB(1, 0), cB + kstep, voffB); PG8_STAGE(PG8_SA(1, 0), cA + kstep, voffA); PG8_STAGE(PG8_SB(1, 1), cB + hstep + kstep, voffB);
        PG8_WAIT_V(6); PG8_BAR;
    } else {
        PG8_STAGE(PG8_SB(0, 0), cB, voffB); PG8_STAGE(PG8_SA(0, 0), cA, voffA); PG8_STAGE(PG8_SB(0, 1), cB + hstep, voffB); PG8_STAGE(PG8_SA(0, 1), cA + hstep, voffA);
        if (wr == 1) PG8_BAR;
        PG8_WAIT_V(4); PG8_BAR;
        PG8_STAGE(PG8_SB(1, 0), cB + kstep, voffB); PG8_STAGE(PG8_SA(1, 0), cA + kstep, voffA); PG8_STAGE(PG8_SB(1, 1), cB + hstep + kstep, voffB);
        PG8_WAIT_V(6); PG8_BAR;
    }
    for (;;) {
        const bool has_next = S.next(ui + 1, nxt);
        const char* nA = has_next ? (const char*)g.A + (size_t)nxt.pm * tstep : cA; const char* nB = has_next ? (const char*)g.Bt + (size_t)nxt.pn * tstep : cB;
        for (int t = 0; t < nt; t += 2) {
            const bool last = (t == nt - 2);
            const char* a1 = cA + (size_t)(t + 1) * kstep;
            const char* a2 = last ? nA : cA + (size_t)(t + 2) * kstep; const char* b2 = last ? nB : cB + (size_t)(t + 2) * kstep;
            const char* a3 = a2 + kstep; const char* b3 = b2 + kstep;
            if (last && has_next) S.a_ready(nxt);
            if constexpr (SP2) {
            PG8_LDB(B0, 0, 0); PG8_LDB(B1, 0, 1); PG8_SCHED; PG8_LDA(At, 0, 0); PG8_STAGE(PG8_SA(1, 1), a1 + hstep, voffA);
            PG8_WAIT_V(8); PG8_WAIT_L(0); PG8_BAR; PG8_MMA(0, 0, At, B0); PG8_MMA(0, 1, At, B1); PG8_BAR; PG8_SCHED;
            PG8_LDA(At, 0, 1); PG8_STAGE(PG8_SB(0, 0), b2, voffB); PG8_STAGE(PG8_SB(0, 1), b2 + hstep, voffB); PG8_STAGE(PG8_SA(0, 0), a2, voffA);
            PG8_WAIT_V(8); PG8_WAIT_L(0); PG8_BAR; PG8_MMA(1, 0, At, B0); PG8_MMA(1, 1, At, B1); PG8_BAR; PG8_SCHED;
            PG8_LDB(B0, 1, 0); PG8_LDB(B1, 1, 1); PG8_SCHED; PG8_LDA(At, 1, 0); PG8_STAGE(PG8_SA(0, 1), a2 + hstep, voffA);
            PG8_WAIT_V(8); PG8_WAIT_L(0); PG8_BAR; PG8_MMA(0, 0, At, B0); PG8_MMA(0, 1, At, B1); PG8_BAR; PG8_SCHED;
            PG8_LDA(At, 1, 1); PG8_STAGE(PG8_SB(1, 0), b3, voffB); PG8_STAGE(PG8_SB(1, 1), b3 + hstep, voffB); PG8_STAGE(PG8_SA(1, 0), a3, voffA);
            PG8_WAIT_V(8); PG8_WAIT_L(0); PG8_BAR; PG8_MMA(1, 0, At, B0); PG8_MMA(1, 1, At, B1); PG8_BAR; PG8_SCHED;
            } else {
            PG8_LDB(B0, 0, 0); PG8_SCHED; PG8_LDA(At, 0, 0); PG8_STAGE(PG8_SA(1, 1), a1 + hstep, voffA);
            PG8_WAIT_L(8); PG8_BAR; PG8_WAIT_L(0); PG8_MMA(0, 0, At, B0); PG8_BAR; PG8_SCHED;
            PG8_LDB(B1, 0, 1); PG8_STAGE(PG8_SB(0, 0), b2, voffB);
            PG8_BAR; PG8_WAIT_L(0); PG8_MMA(0, 1, At, B1); PG8_BAR;
            PG8_LDA(At, 0, 1); PG8_STAGE(PG8_SA(0, 0), a2, voffA);
            PG8_BAR; PG8_WAIT_L(0); PG8_MMA(1, 0, At, B0); PG8_BAR; PG8_SCHED;
            PG8_STAGE(PG8_SB(0, 1), b2 + hstep, voffB);
            PG8_WAIT_V(6); PG8_BAR; PG8_MMA(1, 1, At, B1); PG8_BAR;
            PG8_LDB(B0, 1, 0); PG8_SCHED; PG8_LDA(At, 1, 0); PG8_STAGE(PG8_SA(0, 1), a2 + hstep, voffA);
            PG8_WAIT_L(8); PG8_BAR; PG8_WAIT_L(0); PG8_MMA(0, 0, At, B0); PG8_BAR; PG8_SCHED;
            PG8_LDB(B1, 1, 1); PG8_STAGE(PG8_SB(1, 0), b3, voffB);
            PG8_BAR; PG8_WAIT_L(0); PG8_MMA(0, 1, At, B1); PG8_BAR;
            PG8_LDA(At, 1, 1); PG8_STAGE(PG8_SA(1, 0), a3, voffA);
            PG8_BAR; PG8_WAIT_L(0); PG8_MMA(1, 0, At, B0); PG8_BAR; PG8_SCHED;
            PG8_STAGE(PG8_SB(1, 1), b3 + hstep, voffB);
            PG8_WAIT_V(6); PG8_BAR; PG8_MMA(1, 1, At, B1); PG8_BAR;
            }
        }
        if constexpr (ALIGN_EPI) { if (wr == 0) PG8_BAR; }
        if constexpr (!Epi::AFTER_DRAIN) { E(acc, cur, wr, wc, fr, fq); S.done(cur); }
        if (!has_next) break;
#pragma unroll
        for (int a = 0; a < 2; ++a)
#pragma unroll
            for (int b = 0; b < 2; ++b)
#pragma unroll
                for (int m = 0; m < 4; ++m)
#pragma unroll
                    for (int n = 0; n < 2; ++n) acc[a][b][m][n] = (f32x4){0.f, 0.f, 0.f, 0.f};
        cur = nxt; cA = nA; cB = nB; ++ui;
        if constexpr (ALIGN_EPI) { if (wr == 1) PG8_BAR; }
    }
    PG8_WAIT_V(0);
    if constexpr (!ALIGN_EPI) { if (wr == 0) PG8_BAR; }
    PG8_BAR;
    if constexpr (Epi::AFTER_DRAIN) { E.fused(acc, cur, wr, wc, fr, fq, lds, wid, lane); S.done(cur); }
#undef PG8_SA
#undef PG8_SB
#undef PG8_STAGE
#undef PG8_LDA
#undef PG8_LDB
#undef PG8_MMA
#undef PG8_WAIT_V
#undef PG8_WAIT_L
#undef PG8_BAR
#undef PG8_SCHED
}
}
typedef unsigned short bf16;
constexpr int S_ = 8192, DM = 2048, DIN = 6656, DF = 512, DD = 1024, DG = 512, NH = 8, DEPTH = 2;
constexpr int OFF_AIN = 0, OFF_AG = 512, OFF_Q = 1024, OFF_K = 2048, OFF_V = 3072, OFF_BG = 4096, OFF_U = 5120, OFF_VS = 5632, OFF_CG = 6144;
constexpr float EPS = 1e-6f;
constexpr float LAMBDA_INIT0 = 0.2f;
constexpr float LAMBDA_INIT1 = 0.35550906759f;
__host__ __device__ __forceinline__ float lambda_init(int l) { return l == 0 ? LAMBDA_INIT0 : LAMBDA_INIT1; }

__device__ __forceinline__ unsigned f2bf(float f) { unsigned u = __builtin_bit_cast(unsigned, f); return (u + 0x7fffu + ((u >> 16) & 1u)) >> 16; }
__device__ __forceinline__ float bf2f(unsigned short b) { return __builtin_bit_cast(float, (unsigned)b << 16); }
__device__ __forceinline__ float wave_sum(float v) {
#pragma unroll
    for (int o = 1; o < 64; o <<= 1) v += __shfl_xor(v, o);
    return v;
}
__device__ __forceinline__ float wave_max(float v) {
#pragma unroll
    for (int o = 1; o < 64; o <<= 1) v = fmaxf(v, __shfl_xor(v, o));
    return v;
}
__device__ __forceinline__ float silu(float x) { return x / (1.f + __expf(-x)); }

constexpr size_t MiB = 1u << 20;
constexpr size_t WS_CTL = 0;
constexpr size_t WS_TAB = 64 * 1024;
constexpr size_t WS_BIAS = 192 * 1024;
constexpr size_t WS_LAM = 256 * 1024;
constexpr size_t WS_RSTDSG = 512 * 1024;
constexpr size_t WS_WINT = 1 * MiB;
constexpr size_t WS_WOUTT = 54 * MiB;
constexpr size_t WS_WF2T = 70 * MiB;
constexpr size_t WS_XN = 72 * MiB;
constexpr size_t WS_PROJ = 104 * MiB;
constexpr size_t WS_TP = 208 * MiB;
constexpr size_t WS_X2 = 224 * MiB;
constexpr size_t WS_Y = 240 * MiB;
constexpr size_t WS_YOUT = 272 * MiB;
constexpr size_t WS_END = 336 * MiB;

#define LAS __attribute__((address_space(3)))
#define GAS __attribute__((address_space(1)))
typedef unsigned v4u __attribute__((ext_vector_type(4)));
constexpr int NTHR = 512, NWAVES = 8;
constexpr int LDS_BYTES = 147456;
#define LDS_WAIT() asm volatile("s_waitcnt lgkmcnt(0)" ::: "memory")
__device__ __forceinline__ unsigned pk2(float lo, float hi) { return f2bf(lo) | (f2bf(hi) << 16); }

__device__ __forceinline__ void p0_transpose_item(const float* W, int K, int N, bf16* WT, LAS float* scr, int item, int lane) {
    const int nblk = N / 32, kb = item / nblk, nb = item % nblk, k0 = 64 * kb, n0 = 32 * nb;
#pragma unroll 8
    for (int i = 0; i < 32; ++i) { const int kk = 2 * i + (lane >> 5); scr[kk * 33 + (lane & 31)] = W[(size_t)(k0 + kk) * N + n0 + (lane & 31)]; }
    LDS_WAIT(); asm volatile("" ::: "memory");
    const int c = lane & 7;
#pragma unroll
    for (int j = 0; j < 4; ++j) { const int n = (lane >> 3) + 8 * j; const LAS float* s = scr + (8 * c) * 33 + n;
        v4u o; o.x = pk2(s[0 * 33], s[1 * 33]); o.y = pk2(s[2 * 33], s[3 * 33]); o.z = pk2(s[4 * 33], s[5 * 33]); o.w = pk2(s[6 * 33], s[7 * 33]);
        *(v4u*)(WT + (size_t)(n0 + n) * K + k0 + 8 * c) = o; }
    LDS_WAIT(); asm volatile("" ::: "memory");
}
__device__ __forceinline__ void rms_row_to_bf16(const float4 (&v)[8], const float* gain, bf16* xnrow, int lane) {
    float ss = 0.f;
#pragma unroll
    for (int j = 0; j < 8; ++j) ss += v[j].x * v[j].x + v[j].y * v[j].y + v[j].z * v[j].z + v[j].w * v[j].w;
    const float rstd = rsqrtf(wave_sum(ss) * (1.f / DM) + EPS);
    const float4* gr = (const float4*)gain + lane; uint2* o = (uint2*)xnrow + lane;
#pragma unroll
    for (int j = 0; j < 8; ++j) { const float4 g = gr[64 * j];
        o[64 * j] = make_uint2(pk2(v[j].x * rstd * g.x, v[j].y * rstd * g.y), pk2(v[j].z * rstd * g.z, v[j].w * rstd * g.w)); }
}
#define GTID ((int)(blockIdx.x * NTHR) + fresh_tid())
#define GSIZE ((int)(gridDim.x * NTHR))
#define GWAVE ((int)(blockIdx.x * NWAVES) + (fresh_tid() >> 6))
#define GNWAVES ((int)(gridDim.x * NWAVES))
__device__ __forceinline__ int t5_bucket(int rel) {
    const int ret = rel > 0 ? 16 : 0; const int n = rel < 0 ? -rel : rel;
    if (n < 8) return ret + n;
    int j = 0; while (j < 7 && (64 << (j + 1)) <= n * n) ++j;
    return ret + 8 + j;
}
__device__ __forceinline__ void ph_wf2(const float* __restrict__ wf, bf16* __restrict__ Wf2T) {
    for (int idx = GTID; idx < 512 * 1024; idx += GSIZE) {
        const int j = idx >> 10, pc = idx & 1023, part = pc >> 9, c = pc & 511, g = c >> 7, n3 = c & 127;
        float acc = 0.f;
        for (int k3 = 0; k3 < 128; ++k3) { const int a = (k3 * n3) & 127; float sn, cs; sincospif((float)a * (1.f / 64.f), &sn, &cs);
            acc += (part ? sn : cs) * wf[(size_t)(g * 128 + k3) * 512 + j]; }
        Wf2T[idx] = (bf16)f2bf(acc * 9.765625e-4f); }
}
__device__ __forceinline__ void ph_tables(const float* __restrict__ rel_bias, const float* __restrict__ lambda_qk, float2* __restrict__ trig, float* __restrict__ biasTab, float* __restrict__ biasTab8, float* __restrict__ lam) {
    for (int idx = GTID; idx < 8192; idx += GSIZE) {
        { float sn, cs; sincospif((float)idx * (1.f / 4096.f), &sn, &cs); trig[idx] = make_float2(cs, sn); }
        if (idx < 8 * 272) { const int h = idx / 272, i = idx % 272; int rel = i - 128; if (rel > 128) rel = 128; const float bv = rel_bias[t5_bucket(rel) * 8 + h]; biasTab[idx] = bv; }
        if (idx < 8 * 512) { const int h = idx >> 9; int rel = (idx & 511) - 256; rel = rel < -128 ? -128 : (rel > 128 ? 128 : rel); biasTab8[idx] = 8.f * rel_bias[t5_bucket(rel) * 8 + h]; }
        if (idx < 2) { const float* lq = lambda_qk + idx * 256; float a = 0.f, b = 0.f; for (int i = 0; i < 64; ++i) { a += lq[i] * lq[64 + i]; b += lq[128 + i] * lq[192 + i]; }
            lam[idx] = expf(a) - expf(b) + lambda_init(idx); } }
}
__device__ __forceinline__ void ph_f1_naive(const bf16* __restrict__ proj, const float2* __restrict__ trig, bf16* __restrict__ Tp) {
    for (int idx = GTID; idx < 128 * 64 * 512; idx += GSIZE) { const int c = idx & 511, n2 = (idx >> 9) & 63, k1 = idx >> 15;
        float tr = 0.f, ti = 0.f;
        for (int n1 = 0; n1 < 128; ++n1) { const float a = bf2f(proj[(size_t)(64 * n1 + n2) * DIN + OFF_AIN + c]); const float2 cs = trig[((n1 * k1) & 127) * 64]; tr += a * cs.x; ti -= a * cs.y; }
        const float2 tw = trig[k1 * n2];
        const float pr = tr * tw.x + ti * tw.y, pi = ti * tw.x - tr * tw.y;
        Tp[((size_t)(k1 * 64 + n2) * 2 + 0) * 512 + c] = (bf16)f2bf(pr); Tp[((size_t)(k1 * 64 + n2) * 2 + 1) * 512 + c] = (bf16)f2bf(pi); }
}
__device__ __forceinline__ void ph_f2_naive(const bf16* __restrict__ Tp, const float2* __restrict__ trig, bf16* __restrict__ X2) {
    for (int idx = GTID; idx < 128 * 64 * 512; idx += GSIZE) { const int c = idx & 511, k2 = (idx >> 9) & 63, k1 = idx >> 15;
        float xr = 0.f, xi = 0.f;
        for (int n2 = 0; n2 < 64; ++n2) { const float tr = bf2f(Tp[((size_t)(k1 * 64 + n2) * 2 + 0) * 512 + c]), ti = bf2f(Tp[((size_t)(k1 * 64 + n2) * 2 + 1) * 512 + c]);
            const float2 cs = trig[((n2 * k2) & 63) * 128]; xr += tr * cs.x + ti * cs.y; xi += ti * cs.x - tr * cs.y; }
        X2[(size_t)(k1 * 64 + k2) * 1024 + c] = (bf16)f2bf(xr); X2[(size_t)(k1 * 64 + k2) * 1024 + 512 + c] = (bf16)f2bf(xi); }
}
__device__ __forceinline__ void ph_ya_naive(const bf16* __restrict__ X2, const bf16* __restrict__ Wf2T, const bf16* __restrict__ proj, bf16* __restrict__ Y) {
    for (int idx = GTID; idx < 8192 * 512; idx += GSIZE) { const int j = idx & 511, rho = idx >> 9, k1 = rho >> 6, k2 = rho & 63, row = k1 + 128 * k2;
        float acc = 0.f;
        for (int pc = 0; pc < 1024; ++pc) acc += bf2f(X2[(size_t)rho * 1024 + pc]) * bf2f(Wf2T[(size_t)j * 1024 + pc]);
        Y[(size_t)row * DM + j] = (bf16)f2bf(acc * silu(bf2f(proj[(size_t)row * DIN + OFF_AG + j]))); }
}
__device__ __forceinline__ void ph_sgu_rstd(const bf16* __restrict__ proj, float* __restrict__ rstd_sg) {
    for (int idx = GTID; idx < 8192 * 4; idx += GSIZE) { const int g = idx & 3, pos = idx >> 2;
        float ss = 0.f; for (int c = 0; c < 128; ++c) { const float v = bf2f(proj[(size_t)pos * DIN + OFF_VS + g * 128 + c]); ss += v * v; }
        rstd_sg[idx] = rsqrtf(ss * (1.f / 128.f) + EPS); }
}
__device__ __forceinline__ void ph_sgu_naive(const bf16* __restrict__ proj, const float* __restrict__ rstd_sg, const float* __restrict__ vgain, const float* __restrict__ ws, const float* __restrict__ bs, bf16* __restrict__ Y) {
    for (int idx = GTID; idx < 8192 * 512; idx += GSIZE) { const int gc = idx & 511, p = idx >> 9, g = gc >> 7, pp = p & 127, ch = p >> 7;
        float acc = 0.f; const float gn = vgain[gc];
        for (int q = 0; q < 128; ++q) { const int pos = ch * 128 + q; acc += ws[(size_t)(g * 128 + pp) * 128 + q] * (bf2f(proj[(size_t)pos * DIN + OFF_VS + gc]) * rstd_sg[pos * 4 + g] * gn); }
        const float mixed = acc + bs[g * 128 + pp];
        const float u = bf2f(proj[(size_t)p * DIN + OFF_U + gc]);
        Y[(size_t)p * DM + 1536 + gc] = (bf16)f2bf(u * mixed * silu(bf2f(proj[(size_t)p * DIN + OFF_CG + gc]))); }
}
__device__ __forceinline__ void ph_attn_naive(const bf16* __restrict__ proj, const float* __restrict__ biasTab, const float* __restrict__ lamp, const float* __restrict__ ogain, int layer, bf16* __restrict__ Y) {
  const int lane = fresh_tid() & 63;
  for (int w = GWAVE; w < NH * S_; w += GNWAVES) { const int h = w >> 13, q = w & 8191;
    float qv[128];
    { const bf16* qp = proj + (size_t)q * DIN + OFF_Q + h * 128;
#pragma unroll
      for (int d = 0; d < 128; ++d) qv[d] = bf2f(qp[d]) * 0.125f; }
    const float* bt = biasTab + h * 272 + 128;
    float m0 = -1e30f, m1 = -1e30f, l0 = 0.f, l1 = 0.f;
    for (int t = 0; t < 128; ++t) { const int k = t * 64 + lane; const uint4* kp = (const uint4*)(proj + (size_t)k * DIN + OFF_K + h * 128);
        float s0 = 0.f, s1 = 0.f;
#pragma unroll
        for (int i = 0; i < 16; ++i) { const uint4 kk = kp[i]; const unsigned wv[4] = {kk.x, kk.y, kk.z, kk.w};
#pragma unroll
            for (int e = 0; e < 4; ++e) { const float a = __builtin_bit_cast(float, wv[e] << 16), b = __builtin_bit_cast(float, wv[e] & 0xffff0000u);
                if (i < 8) s0 += qv[i * 8 + e * 2] * a + qv[i * 8 + e * 2 + 1] * b; else s1 += qv[i * 8 + e * 2] * a + qv[i * 8 + e * 2 + 1] * b; } }
        int rel = k - q; rel = rel < -128 ? -128 : (rel > 128 ? 128 : rel); const float b = bt[rel]; s0 += b; s1 += b;
        { const float mn = fmaxf(m0, s0); l0 = l0 * __expf(m0 - mn) + __expf(s0 - mn); m0 = mn; }
        { const float mn = fmaxf(m1, s1); l1 = l1 * __expf(m1 - mn) + __expf(s1 - mn); m1 = mn; } }
    { const float M0 = wave_max(m0), M1 = wave_max(m1); l0 = wave_sum(l0 * __expf(m0 - M0)); l1 = wave_sum(l1 * __expf(m1 - M1)); m0 = M0; m1 = M1; }
    const float lam = lamp[layer], il0 = 1.f / l0, il1 = lam / l1;
    float acc0 = 0.f, acc1 = 0.f;
    for (int t = 0; t < 128; ++t) { const int k = t * 64 + lane; const uint4* kp = (const uint4*)(proj + (size_t)k * DIN + OFF_K + h * 128);
        float s0 = 0.f, s1 = 0.f;
#pragma unroll
        for (int i = 0; i < 16; ++i) { const uint4 kk = kp[i]; const unsigned wv[4] = {kk.x, kk.y, kk.z, kk.w};
#pragma unroll
            for (int e = 0; e < 4; ++e) { const float a = __builtin_bit_cast(float, wv[e] << 16), b = __builtin_bit_cast(float, wv[e] & 0xffff0000u);
                if (i < 8) s0 += qv[i * 8 + e * 2] * a + qv[i * 8 + e * 2 + 1] * b; else s1 += qv[i * 8 + e * 2] * a + qv[i * 8 + e * 2 + 1] * b; } }
        int rel = k - q; rel = rel < -128 ? -128 : (rel > 128 ? 128 : rel); const float b = bt[rel]; s0 += b; s1 += b;
        const float wgt = __expf(s0 - m0) * il0 - __expf(s1 - m1) * il1;
        const unsigned* vp = (const unsigned*)(proj + (size_t)(t * 64) * DIN + OFF_V + h * 128) + lane;
        for (int kk = 0; kk < 64; ++kk) { const float wk = __shfl(wgt, kk); const unsigned vv = vp[(size_t)kk * (DIN / 2)];
            acc0 += wk * __builtin_bit_cast(float, vv << 16); acc1 += wk * __builtin_bit_cast(float, vv & 0xffff0000u); } }
    const float rstd = rsqrtf(wave_sum(acc0 * acc0 + acc1 * acc1) * (1.f / 128.f) + EPS) * (1.f - lambda_init(layer));
    const int col = h * 128 + 2 * lane;
    const float y0 = acc0 * rstd * ogain[col] * silu(bf2f(proj[(size_t)q * DIN + OFF_BG + col]));
    const float y1 = acc1 * rstd * ogain[col + 1] * silu(bf2f(proj[(size_t)q * DIN + OFF_BG + col + 1]));
    *(unsigned*)(Y + (size_t)q * DM + 512 + col) = f2bf(y0) | (f2bf(y1) << 16);
  }
}
namespace dattn {
using bf16x8 = __attribute__((ext_vector_type(8))) short;
using s16x4  = __attribute__((ext_vector_type(4))) short;
using f32x16 = __attribute__((ext_vector_type(16))) float;
using u32x4  = __attribute__((ext_vector_type(4))) unsigned;
using f32x4v = __attribute__((ext_vector_type(4))) float;
constexpr int QBLK = 32, KVBLK = 64;
constexpr float SCALE = 0.125f, THR = 8.f;
#ifndef DATTN_SDEPTH
#define DATTN_SDEPTH 1
#endif
constexpr int SDEPTH = DATTN_SDEPTH;
constexpr size_t SHM_V = KVBLK * 128 * 2, SHM_K = KVBLK * 128 * 2, SHM_ATTN = 2 * SHM_V + 2 * SHM_K + 8 * 64 * 4;
#define KSWZ(row, colB) ((row) * 256 + ((colB) ^ (((row) & 7) << 4)))
#define SBAR() __builtin_amdgcn_sched_barrier(0)
__device__ __forceinline__ int crow(int r, int hi) { return (r & 3) + 8 * (r >> 2) + 4 * hi; }
__device__ __forceinline__ unsigned cvtpk(float lo, float hi) { unsigned r; asm volatile("v_cvt_pk_bf16_f32 %0, %1, %2" : "=v"(r) : "v"(lo), "v"(hi)); return r; }
__device__ __forceinline__ void partialSM(f32x16& p0, f32x16& p1, float& m_reg, float& mn, float& alpha) {
  constexpr float C = SCALE * 1.4426950408889634f;
  float pmax = p0[0]; for (int r = 1; r < 16; ++r) pmax = fmaxf(pmax, p0[r]); for (int r = 0; r < 16; ++r) pmax = fmaxf(pmax, p1[r]);
  { auto rr = __builtin_amdgcn_permlane32_swap(__float_as_uint(pmax), __float_as_uint(pmax), false, false);
    pmax = fmaxf(__uint_as_float(rr[0]), __uint_as_float(rr[1])); }
  if (__builtin_expect(__all(pmax - m_reg <= THR / SCALE), 1)) { mn = m_reg; alpha = 1.f; }
  else { mn = fmaxf(m_reg, pmax); alpha = __builtin_amdgcn_exp2f((m_reg - mn) * C); m_reg = mn; }
  float mnC = -mn * C;
  for (int r = 0; r < 16; ++r) p0[r] = fmaf(p0[r], C, mnC); for (int r = 0; r < 16; ++r) p1[r] = fmaf(p1[r], C, mnC);
  for (int r = 0; r < 16; ++r) p0[r] = __builtin_amdgcn_exp2f(p0[r]);
}
__device__ __forceinline__ void finishSM(f32x16& p0, f32x16& p1, float alpha, float& l_reg, bf16x8& pa0, bf16x8& pa1, bf16x8& pa2, bf16x8& pa3) {
  for (int r = 0; r < 16; ++r) p1[r] = __builtin_amdgcn_exp2f(p1[r]);
  float ps = 0; for (int r = 0; r < 16; ++r) ps += p0[r]; for (int r = 0; r < 16; ++r) ps += p1[r];
  { auto rr = __builtin_amdgcn_permlane32_swap(__float_as_uint(ps), __float_as_uint(ps), false, false);
    ps = __uint_as_float(rr[0]) + __uint_as_float(rr[1]); }
  l_reg = l_reg * alpha + ps;
#define PK4(P, BASE, OUT) do { unsigned a0 = cvtpk(P[BASE + 0], P[BASE + 1]), a1 = cvtpk(P[BASE + 2], P[BASE + 3]);   \
    unsigned b0 = cvtpk(P[BASE + 4], P[BASE + 5]), b1 = cvtpk(P[BASE + 6], P[BASE + 7]);                              \
    auto r0 = __builtin_amdgcn_permlane32_swap(a0, b0, false, false); auto r1 = __builtin_amdgcn_permlane32_swap(a1, b1, false, false); \
    u32x4 w = {r0[0], r1[0], r0[1], r1[1]}; OUT = *reinterpret_cast<bf16x8*>(&w); } while (0)
  PK4(p0, 0, pa0); PK4(p0, 8, pa1); PK4(p1, 0, pa2); PK4(p1, 8, pa3);
#undef PK4
}
__device__ __forceinline__ void qkt(f32x16& p0, f32x16& p1, const bf16* Ks, const bf16x8* qr, int r32, int hi, int cbase) {
#pragma unroll
  for (int d0 = 0; d0 < 4; ++d0) { int cb = (cbase + d0 * 16 + hi * 8) * 2;
    bf16x8 b0 = *reinterpret_cast<const bf16x8*>((const char*)Ks + KSWZ(r32, cb));
    bf16x8 b1 = *reinterpret_cast<const bf16x8*>((const char*)Ks + KSWZ(32 + r32, cb));
    p0 = __builtin_amdgcn_mfma_f32_32x32x16_bf16(b0, qr[d0], p0, 0, 0, 0);
    p1 = __builtin_amdgcn_mfma_f32_32x32x16_bf16(b1, qr[d0], p1, 0, 0, 0); }
}
__device__ __forceinline__ int v_st(int k, int c) { const int kk = (k & ~0xC) | ((k & 4) << 1) | ((k & 8) >> 1); return ((kk >> 3) * 4 + (c >> 5)) * 512 + ((kk & 7) * 32 + (c & 31)) * 2; }
__device__ __forceinline__ int v_rd_base(int lane) { return ((lane & 3) << 3) | (((lane >> 2) & 3) << 6) | (((lane >> 4) & 1) << 5) | (((lane >> 5) & 1) << 8); }
constexpr int v_rd_off(int d0, int ks, int half) { return d0 * 512 + ks * 4096 + half * 2048; }
template <int OFF> __device__ __forceinline__ s16x4 tr_read(int vb) {
  s16x4 r; asm volatile("ds_read_b64_tr_b16 %0, %1 offset:%2" : "=&v"(r) : "v"(vb), "i"(OFF) : "memory"); return r;
}
template <int D0> __device__ __forceinline__ void pv_one(f32x16& od, int vb, bf16x8 pa0, bf16x8 pa1, bf16x8 pa2, bf16x8 pa3) {
  const s16x4 l0 = tr_read<v_rd_off(D0, 0, 0)>(vb), h0 = tr_read<v_rd_off(D0, 0, 1)>(vb), l1 = tr_read<v_rd_off(D0, 1, 0)>(vb), h1 = tr_read<v_rd_off(D0, 1, 1)>(vb);
  const s16x4 l2 = tr_read<v_rd_off(D0, 2, 0)>(vb), h2 = tr_read<v_rd_off(D0, 2, 1)>(vb), l3 = tr_read<v_rd_off(D0, 3, 0)>(vb), h3 = tr_read<v_rd_off(D0, 3, 1)>(vb);
  asm volatile("s_waitcnt lgkmcnt(0)" ::: "memory"); SBAR();
#define PK(L, H) (bf16x8){L[0], L[1], L[2], L[3], H[0], H[1], H[2], H[3]}
  od = __builtin_amdgcn_mfma_f32_32x32x16_bf16(pa0, PK(l0, h0), od, 0, 0, 0);
  od = __builtin_amdgcn_mfma_f32_32x32x16_bf16(pa1, PK(l1, h1), od, 0, 0, 0);
  od = __builtin_amdgcn_mfma_f32_32x32x16_bf16(pa2, PK(l2, h2), od, 0, 0, 0);
  od = __builtin_amdgcn_mfma_f32_32x32x16_bf16(pa3, PK(l3, h3), od, 0, 0, 0);
#undef PK
}
__device__ __forceinline__ void pv_d0(f32x16* o, int vb, bf16x8 pa0, bf16x8 pa1, bf16x8 pa2, bf16x8 pa3) {
  pv_one<0>(o[0], vb, pa0, pa1, pa2, pa3); pv_one<1>(o[1], vb, pa0, pa1, pa2, pa3); pv_one<2>(o[2], vb, pa0, pa1, pa2, pa3); pv_one<3>(o[3], vb, pa0, pa1, pa2, pa3);
}
__device__ __forceinline__ void bias_init(f32x16& p0, f32x16& p1, int k0, int qwave, int qpos, const float* btl, float bL, float bR, int hi) {
  if (k0 + 63 - qwave <= -128) { for (int r = 0; r < 16; ++r) { p0[r] = bL; p1[r] = bL; } }
  else if (k0 - qwave - 31 >= 128) { for (int r = 0; r < 16; ++r) { p0[r] = bR; p1[r] = bR; } }
  else { const float* b = btl + (256 + k0 - qpos + 4 * hi);
#pragma unroll
    for (int r = 0; r < 16; ++r) { p0[r] = b[(r & 3) + 8 * (r >> 2)]; p1[r] = b[(r & 3) + 8 * (r >> 2) + 32]; }
  }
}

__device__ __forceinline__ void dattn_unit(int h, int qb, const bf16* __restrict__ proj, const float* __restrict__ bt8, float lam, float oscale, const float* __restrict__ ogain, bf16* __restrict__ Y, char* lds) {
  const int tid = fresh_tid(), wid = tid >> 6, lane = tid & 63, r32 = lane & 31, hi = lane >> 5, cmap = wid >> 2, wq = wid & 3;
  const int qwave = qb * 128 + wq * QBLK, qpos = qwave + r32;
  bf16* V_lds = (bf16*)lds; bf16* K_lds = (bf16*)(lds + 2 * SHM_V);
  float* wsf = (float*)(lds + 2 * SHM_V + 2 * SHM_K) + wid * 64; float* li_l = wsf; float* al_l = wsf + 32;
  float m_reg = -1e30f, l_reg = 0; f32x16 o[4] = {}; bf16x8 qr[4];
  const bf16* Qw = proj + (size_t)qpos * DIN + OFF_Q + h * 128 + cmap * 64 + hi * 8;
#pragma unroll
  for (int d0 = 0; d0 < 4; ++d0) qr[d0] = *reinterpret_cast<const bf16x8*>(Qw + d0 * 16);
  const bf16* Kh = proj + OFF_K + h * 128; const bf16* Vh = proj + OFF_V + h * 128;
  float* btl = (float*)(lds + 69632);
  btl[tid] = bt8[tid];
  const float bL = bt8[0], bR = bt8[511];
  const int cbase = cmap * 64;
  const int sr = tid >> 4, sc = (tid & 15) * 8, vst0 = v_st(sr, sc), vst1 = v_st(32 + sr, sc);
  const int vb0 = (int)(uintptr_t)V_lds + v_rd_base(lane);
  struct { bf16x8 vs0, vs1, ks0, ks1; } sr_[SDEPTH];
#define LD8(p) (*reinterpret_cast<const bf16x8*>(p))
#define SLOAD(i, k0) do { sr_[i].vs0 = LD8(&Vh[(size_t)((k0) + sr) * DIN + sc]); sr_[i].vs1 = LD8(&Vh[(size_t)((k0) + 32 + sr) * DIN + sc]); \
    sr_[i].ks0 = LD8(&Kh[(size_t)((k0) + sr) * DIN + sc]); sr_[i].ks1 = LD8(&Kh[(size_t)((k0) + 32 + sr) * DIN + sc]); } while (0)
#define SWRITE(b, i) do { *(bf16x8*)((char*)V_lds + (b) * SHM_V + vst0) = sr_[i].vs0;          \
    *(bf16x8*)((char*)V_lds + (b) * SHM_V + vst1) = sr_[i].vs1; int kc = sc * 2;               \
    *(bf16x8*)((char*)K_lds + (b) * SHM_K + KSWZ(sr, kc)) = sr_[i].ks0;                       \
    *(bf16x8*)((char*)K_lds + (b) * SHM_K + KSWZ(32 + sr, kc)) = sr_[i].ks1; } while (0)
#define SWAIT() do { if constexpr (SDEPTH == 2) asm volatile("s_waitcnt vmcnt(4)" ::: "memory"); else asm volatile("s_waitcnt vmcnt(0)" ::: "memory"); } while (0)
#define RESC(a) do { if (__any((a) < 1.f)) { if (hi == 0) al_l[r32] = (a); asm volatile("s_waitcnt lgkmcnt(0)" ::: "memory"); \
    for (int d = 0; d < 4; ++d) for (int r = 0; r < 16; ++r) o[d][r] *= al_l[crow(r, hi)]; } } while (0)
#define BINIT(P0, P1, t) bias_init(P0, P1, (t) * KVBLK, qwave, qpos, btl, bL, bR, hi)
  f32x16 pA0, pA1, pB0, pB1; float mnA, mnB, alA, alB; bf16x8 pa0, pa1, pa2, pa3; constexpr int NT = S_ / KVBLK;
  constexpr int SE = 0, SO = SDEPTH - 1;
  SLOAD(SE, 0); asm volatile("s_waitcnt vmcnt(0)" ::: "memory"); SWRITE(0, SE); __syncthreads();
  BINIT(pA0, pA1, 0); qkt(pA0, pA1, K_lds, qr, r32, hi, cbase); partialSM(pA0, pA1, m_reg, mnA, alA);
  SLOAD(SO, KVBLK); if constexpr (SDEPTH == 2) SLOAD(SE, 2 * KVBLK);
  SWAIT(); SWRITE(1, SO); __syncthreads();
  for (int j = 1; j + 1 < NT; j += 2) {
    BINIT(pB0, pB1, j);
    SBAR(); qkt(pB0, pB1, (bf16*)((char*)K_lds + SHM_K), qr, r32, hi, cbase);
    finishSM(pA0, pA1, alA, l_reg, pa0, pa1, pa2, pa3); SBAR();
    SLOAD(SO, (j + SDEPTH) * KVBLK); SBAR();
    pv_d0(o, vb0, pa0, pa1, pa2, pa3); partialSM(pB0, pB1, m_reg, mnB, alB);
    __syncthreads(); SWAIT(); SWRITE(0, SE);
    RESC(alB); __syncthreads();
    BINIT(pA0, pA1, j + 1);
    SBAR(); qkt(pA0, pA1, K_lds, qr, r32, hi, cbase);
    finishSM(pB0, pB1, alB, l_reg, pa0, pa1, pa2, pa3); SBAR();
    if (SDEPTH == 1 || j + 3 < NT) SLOAD(SE, (j + 1 + SDEPTH) * KVBLK); SBAR();
    pv_d0(o, vb0 + (int)SHM_V, pa0, pa1, pa2, pa3); partialSM(pA0, pA1, m_reg, mnA, alA);
    __syncthreads(); SWAIT(); SWRITE(1, SO);
    RESC(alA); __syncthreads();
  }
  BINIT(pB0, pB1, NT - 1);
  SBAR(); qkt(pB0, pB1, (bf16*)((char*)K_lds + SHM_K), qr, r32, hi, cbase);
  finishSM(pA0, pA1, alA, l_reg, pa0, pa1, pa2, pa3); SBAR();
  pv_d0(o, vb0, pa0, pa1, pa2, pa3); partialSM(pB0, pB1, m_reg, mnB, alB);
  __syncthreads(); RESC(alB);
  finishSM(pB0, pB1, alB, l_reg, pa0, pa1, pa2, pa3); SBAR();
  pv_d0(o, vb0 + (int)SHM_V, pa0, pa1, pa2, pa3);
  if (hi == 0) li_l[r32] = l_reg; asm volatile("s_waitcnt lgkmcnt(0)" ::: "memory");
  { const float f = cmap ? lam : 1.f;
#pragma unroll
    for (int r = 0; r < 16; ++r) { const float rl = __builtin_amdgcn_rcpf(li_l[crow(r, hi)]) * f;
#pragma unroll
      for (int d0 = 0; d0 < 4; ++d0) o[d0][r] *= rl; } }
  __syncthreads();
  float* X = (float*)lds + wq * 4224;
  if (cmap == 1) {
#pragma unroll
    for (int d0 = 0; d0 < 4; ++d0)
#pragma unroll
      for (int r = 0; r < 16; ++r) X[(d0 * 16 + r) * 64 + lane] = o[d0][r];
  }
  __syncthreads();
  if (cmap == 0) {
    float ss[16];
#pragma unroll
    for (int r = 0; r < 16; ++r) { float s = 0.f;
#pragma unroll
      for (int d0 = 0; d0 < 4; ++d0) { const float v = o[d0][r] - X[(d0 * 16 + r) * 64 + lane]; o[d0][r] = v; s += v * v; }
      ss[r] = s; }
#pragma unroll
    for (int r = 0; r < 16; ++r) { float s = ss[r]; s += __shfl_xor(s, 1); s += __shfl_xor(s, 2); s += __shfl_xor(s, 4); s += __shfl_xor(s, 8); s += __shfl_xor(s, 16);
      ss[r] = rsqrtf(s * (1.f / 128.f) + EPS) * oscale; }
    asm volatile("s_waitcnt lgkmcnt(0)" ::: "memory");
#pragma unroll
    for (int r = 0; r < 16; ++r)
#pragma unroll
      for (int d0 = 0; d0 < 4; ++d0) X[crow(r, hi) * 132 + d0 * 32 + r32] = o[d0][r] * ss[r];
    asm volatile("s_waitcnt lgkmcnt(0)" ::: "memory");
    const int ch = lane & 15;
    const f32x4v g0 = *(const f32x4v*)(ogain + ch * 8), g1 = *(const f32x4v*)(ogain + ch * 8 + 4);
#pragma unroll
    for (int it = 0; it < 8; ++it) { const int row = it * 4 + (lane >> 4);
      const f32x4v a = *(const f32x4v*)(X + row * 132 + ch * 8), b = *(const f32x4v*)(X + row * 132 + ch * 8 + 4);
      const size_t grow = (size_t)(qwave + row);
      const u32x4 bg = *(const u32x4*)(proj + grow * DIN + OFF_BG + h * 128 + ch * 8);
      float y[8] = {a[0] * g0[0], a[1] * g0[1], a[2] * g0[2], a[3] * g0[3], b[0] * g1[0], b[1] * g1[1], b[2] * g1[2], b[3] * g1[3]};
      const unsigned bgw[4] = {bg.x, bg.y, bg.z, bg.w};
#pragma unroll
      for (int e = 0; e < 4; ++e) { y[2 * e] *= silu(__builtin_bit_cast(float, bgw[e] << 16)); y[2 * e + 1] *= silu(__builtin_bit_cast(float, bgw[e] & 0xffff0000u)); }
      u32x4 w = {cvtpk(y[0], y[1]), cvtpk(y[2], y[3]), cvtpk(y[4], y[5]), cvtpk(y[6], y[7])};
      *(u32x4*)(Y + grow * DM + 512 + h * 128 + ch * 8) = w; }
  }
  __syncthreads();
#undef LD8
#undef SLOAD
#undef SWRITE
#undef SWAIT
#undef RESC
#undef BINIT
}
#undef KSWZ
#undef SBAR
}
#include <hip/hip_cooperative_groups.h>
namespace cg = cooperative_groups;
struct Args { const float* in[12]; float* out; unsigned char* ws; };
#define GRID_SYNC() grid.sync()
typedef const __attribute__((address_space(4))) unsigned char* kargp_t;
#define KARG(i) (*(const volatile __attribute__((address_space(4))) unsigned long long*)(kargs + 8 * (i)))
#define A_IN(i) ((const float*)(const GAS float*)KARG(i))
#define A_X A_IN(0)
#define A_WIN A_IN(1)
#define A_PREG A_IN(2)
#define A_POSTG A_IN(3)
#define A_WF A_IN(4)
#define A_LQK A_IN(5)
#define A_OGAIN A_IN(6)
#define A_VGAIN A_IN(7)
#define A_WS A_IN(8)
#define A_BS A_IN(9)
#define A_WOUT A_IN(10)
#define A_RELB A_IN(11)
#define A_OUT ((float*)(GAS float*)KARG(12))
#define A_WSP ((unsigned char*)(GAS unsigned char*)KARG(13))
#define W_TRIG ((float2*)(A_WSP + WS_TAB))
#define W_BIAS ((float*)(A_WSP + WS_BIAS))
#define W_BIAS8 ((float*)(A_WSP + WS_BIAS + 16384))
#define W_LAM ((float*)(A_WSP + WS_LAM))
#define W_RSTDSG ((float*)(A_WSP + WS_RSTDSG))
#define W_WINT ((bf16*)(A_WSP + WS_WINT))
#define W_WOUTT ((bf16*)(A_WSP + WS_WOUTT))
#define W_WF2T ((bf16*)(A_WSP + WS_WF2T))
#define W_XN ((bf16*)(A_WSP + WS_XN))
#define W_PROJ ((bf16*)(A_WSP + WS_PROJ))
#define W_TP ((bf16*)(A_WSP + WS_TP))
#define W_X2 ((bf16*)(A_WSP + WS_X2))
#define W_Y ((bf16*)(A_WSP + WS_Y))
#define W_YOUT ((float*)(A_WSP + WS_YOUT))
__global__ void __launch_bounds__(NTHR, 2) mega_fwd(Args a) {
    extern __shared__ __attribute__((aligned(16))) unsigned char lds[];
    cg::grid_group grid = cg::this_grid();
    const kargp_t kargs = (kargp_t)__builtin_amdgcn_kernarg_segment_ptr();
    LAS unsigned char* L = (LAS unsigned char*)lds;

    {
        const int ftid = fresh_tid(); const int lane = ftid & 63, wave = __builtin_amdgcn_readfirstlane(ftid >> 6);
        const int gw = (int)blockIdx.x * NWAVES + wave, NGW = (int)gridDim.x * NWAVES;
        LAS float* scr = (LAS float*)(L + wave * 16384);
        constexpr int I_IN = (DM / 64) * (DIN / 32), I_OUT = (DM / 64) * (DM / 32), I_L = I_IN + I_OUT;
        { const float* w_in = A_WIN; const float* w_out = A_WOUT; bf16* WinT = W_WINT; bf16* WoutT = W_WOUTT;
          for (int it = gw; it < DEPTH * I_L; it += NGW) { const int l = it / I_L, r = it % I_L;
            if (r < I_IN) p0_transpose_item(w_in + (size_t)l * DM * DIN, DM, DIN, WinT + (size_t)l * DIN * DM, scr, r, lane);
            else p0_transpose_item(w_out + (size_t)l * DM * DM, DM, DM, WoutT + (size_t)l * DM * DM, scr, r - I_IN, lane); } }
        ph_wf2(A_WF, W_WF2T); ph_wf2(A_WF + (size_t)DF * DF, W_WF2T + (size_t)512 * 1024);
        ph_tables(A_RELB, A_LQK, W_TRIG, W_BIAS, W_BIAS8, W_LAM);
        { const float* xp = A_X; const float* pg = A_PREG; bf16* XN = W_XN;
          for (int row = gw; row < S_; row += NGW) { const float4* xr = (const float4*)(xp + (size_t)row * DM) + lane; float4 v[8];
#pragma unroll
            for (int j = 0; j < 8; ++j) v[j] = xr[64 * j];
            rms_row_to_bf16(v, pg, XN + (size_t)row * DM, lane); } }
    }
    GRID_SYNC();
#pragma unroll
    for (int l = 0; l < DEPTH; ++l) {
        { pg8::Gemm g{W_XN, W_WINT + (size_t)l * DIN * DM, S_, DIN, DM}; pg8::StaticOrder S; S.init(S_, DIN, (int)gridDim.x, (int)blockIdx.x);
          pg8::EpiBf16 E{W_PROJ, DIN};
          pg8::gemm_phase<pg8::EpiBf16, pg8::StaticOrder, true, true>(L, g, S, E); }
        GRID_SYNC();
        ph_f1_naive(W_PROJ, W_TRIG, W_TP); ph_sgu_rstd(W_PROJ, W_RSTDSG);
        GRID_SYNC();
        ph_f2_naive(W_TP, W_TRIG, W_X2);
        ph_sgu_naive(W_PROJ, W_RSTDSG, A_VGAIN + l * DG, A_WS + (size_t)l * 4 * 128 * 128, A_BS + l * 4 * 128, W_Y);
#ifdef X_NAIVE_ATTN
        ph_attn_naive(W_PROJ, W_BIAS, W_LAM, A_OGAIN + l * DD, l, W_Y);
#else
        { const bf16* proj = W_PROJ; const float* bt8 = W_BIAS8; const float lamv = W_LAM[l]; const float* og = A_OGAIN + l * DD; bf16* Yp = W_Y;
          for (int u = (int)blockIdx.x; u < NH * (S_ / 128); u += (int)gridDim.x) { const int hh = u & 7, qb = u >> 3;
            dattn::dattn_unit(hh, qb, proj, bt8 + hh * 512, lamv, 1.f - lambda_init(l), og + hh * 128, Yp, (char*)lds); } }
#endif
        GRID_SYNC();
        ph_ya_naive(W_X2, W_WF2T + (size_t)l * 512 * 1024, W_PROJ, W_Y);
        GRID_SYNC();
        { pg8::Gemm g{W_Y, W_WOUTT + (size_t)l * DM * DM, S_, DM, DM}; pg8::StaticOrder S; S.init(S_, DM, (int)gridDim.x, (int)blockIdx.x);
          pg8::EpiF32 E{W_YOUT, DM};
          pg8::gemm_phase<pg8::EpiF32, pg8::StaticOrder, true, true>(L, g, S, E); }
        GRID_SYNC();
        { const int ftid = fresh_tid(); const int lane = ftid & 63, wave = __builtin_amdgcn_readfirstlane(ftid >> 6);
          const int gw = (int)blockIdx.x * NWAVES + wave, NGW = (int)gridDim.x * NWAVES;
          const float* yo = W_YOUT; const float* pg = A_POSTG + l * DM; const float* xs = (l == 0 ? A_X : (const float*)A_OUT); float* outp = A_OUT; bf16* XN = W_XN; const float* pre = A_PREG + (l + 1 < DEPTH ? (l + 1) * DM : 0);
          for (int row = gw; row < S_; row += NGW) {
            const float4* yr = (const float4*)(yo + (size_t)row * DM) + lane; const float4* gr = (const float4*)pg + lane; const float4* xr = (const float4*)(xs + (size_t)row * DM) + lane;
            float4 v[8]; float ss = 0.f;
#pragma unroll
            for (int j = 0; j < 8; ++j) { v[j] = yr[64 * j]; ss += v[j].x * v[j].x + v[j].y * v[j].y + v[j].z * v[j].z + v[j].w * v[j].w; }
            const float rstd = rsqrtf(wave_sum(ss) * (1.f / DM) + EPS);
            float4* o = (float4*)(outp + (size_t)row * DM) + lane;
#pragma unroll
            for (int j = 0; j < 8; ++j) { const float4 g = gr[64 * j]; const float4 xv = xr[64 * j];
                v[j] = make_float4(xv.x + v[j].x * rstd * g.x, xv.y + v[j].y * rstd * g.y, xv.z + v[j].z * rstd * g.z, xv.w + v[j].w * rstd * g.w); o[64 * j] = v[j]; }
            if (l + 1 < DEPTH) rms_row_to_bf16(v, pre, XN + (size_t)row * DM, lane);
          } }
        if (l + 1 < DEPTH) GRID_SYNC();
    }
}

extern "C" void kernel_launch(void* const* d_in, const int* in_sizes, int n_in, void* d_out, int out_size, void* d_ws, size_t ws_size, hipStream_t stream) {
    static int grid = 0;
    if (grid == 0) {
        if (n_in != 12 || ws_size < WS_END) { fprintf(stderr, "kernel_launch: unexpected n_in %d / ws %zu\n", n_in, ws_size); grid = -1; return; }
        int dev = 0, cus = 0, per_cu = 0;
        if (hipGetDevice(&dev) != hipSuccess || hipDeviceGetAttribute(&cus, hipDeviceAttributeMultiprocessorCount, dev) != hipSuccess) { grid = -1; return; }
        if (hipFuncSetAttribute((const void*)mega_fwd, hipFuncAttributeMaxDynamicSharedMemorySize, LDS_BYTES) != hipSuccess) { fprintf(stderr, "kernel_launch: hipFuncSetAttribute failed\n"); grid = -1; return; }
        if (hipOccupancyMaxActiveBlocksPerMultiprocessor(&per_cu, (const void*)mega_fwd, NTHR, LDS_BYTES) != hipSuccess || per_cu < 1) { fprintf(stderr, "kernel_launch: occupancy query failed (%d)\n", per_cu); (void)hipGetLastError(); grid = -1; return; }
        grid = cus * per_cu;
    }
    if (grid < 0) return;
    Args a{};
    for (int i = 0; i < 12; ++i) a.in[i] = (const float*)d_in[i];
    a.out = (float*)d_out; a.ws = (unsigned char*)d_ws;
    void* args[] = {&a};
    hipError_t e = hipLaunchCooperativeKernel((const void*)mega_fwd, dim3(grid), dim3(NTHR), args, LDS_BYTES, stream);
    if (e != hipSuccess) fprintf(stderr, "cooperative launch failed: %s (grid %d)\n", hipGetErrorString(e), grid);
}
```

```cpp
#include <hip/hip_runtime.h>
#include <cstdio>
#include <cstdint>
__device__ __forceinline__ int fresh_tid() { int t = (int)threadIdx.x; asm volatile("" : "+v"(t)); return t; }
namespace pg8 {
#define PG8_LAS __attribute__((address_space(3)))
typedef unsigned short bf16_t;
typedef short bf16x8 __attribute__((ext_vector_type(8)));
typedef float f32x4 __attribute__((ext_vector_type(4)));
typedef unsigned u32x4 __attribute__((ext_vector_type(4)));
constexpr int BM = 256, BK = 64, HALF = 128, HTB = HALF * BK * 2  , STAGE_BYTES = 8 * HTB, NXCD = 8, WGM = 8;

__host__ __device__ __forceinline__ int lds_byte(int r, int c) { const int st = (r >> 4) * 2 + (c >> 5), rr = r & 15, cc = c & 31, ob = rr * 64 + cc * 2; return st * 1024 + (ob ^ (((ob >> 9) & 1) << 5)); }
__host__ __device__ __forceinline__ void stage_rc(int b, int& R, int& C) { const int st = b / 1024, sb = b % 1024, swz = sb ^ (((sb >> 9) & 1) << 5); R = (st >> 1) * 16 + swz / 64; C = (st & 1) * 32 + (swz % 64) / 2; }
__host__ __device__ __forceinline__ int perm32(int rho) { const int n = rho >> 4, i = rho & 15; return 8 * (i >> 2) + 4 * n + (i & 3); }

struct Unit { int pm, pn; };
struct Gemm { const bf16_t* A; const bf16_t* Bt; int M, N, K; };

struct StaticOrder {
    int nM, nN, nwg, G, c;
    __host__ __device__ void init(int M, int N, int G_, int c_) { nM = M / BM; nN = N / BM; nwg = nM * nN; G = G_; c = c_; }
    __host__ __device__ bool next(int i, Unit& u) const {
        const long L = (long)i * G + c; if (L >= nwg) return false;
        int wgid = (int)L; { const int q = nwg / NXCD, r = nwg % NXCD, xcd = wgid % NXCD, off = wgid / NXCD; wgid = (xcd < r ? xcd * (q + 1) : r * (q + 1) + (xcd - r) * q) + off; }
        const int nig = WGM * nN, gid = wgid / nig, fm = gid * WGM, gsz = (nM - fm) < WGM ? (nM - fm) : WGM;
        u.pm = fm + ((wgid % nig) % gsz); u.pn = (wgid % nig) / gsz; return true;
    }
    __device__ __forceinline__ void a_ready(const Unit&) const {}
    __device__ __forceinline__ void done(const Unit&) const {}
};

__device__ __forceinline__ unsigned cvt_pk_bf16(float lo, float hi) { unsigned r; asm volatile("v_cvt_pk_bf16_f32 %0, %1, %2" : "=v"(r) : "v"(lo), "v"(hi)); return r; }
struct EpiBf16 {
    static constexpr bool PERM = true, AFTER_DRAIN = false;
    bf16_t* O; int ldc;
    __device__ __forceinline__ void operator()(const f32x4 (&acc)[2][2][4][2], const Unit& u, int wr, int wc, int fr, int fq) const {
        const int row0 = u.pm * BM + wr * 64 + fr; const int col0 = u.pn * BM + wc * 32 + 8 * fq;
#pragma unroll
        for (int ai = 0; ai < 2; ++ai)
#pragma unroll
            for (int m = 0; m < 4; ++m) { bf16_t* rowp = O + (size_t)(row0 + ai * HALF + m * 16) * ldc + col0;
#pragma unroll
                for (int bj = 0; bj < 2; ++bj) { const f32x4 v0 = acc[ai][bj][m][0], v1 = acc[ai][bj][m][1];
                    u32x4 w; w.x = cvt_pk_bf16(v0[0], v0[1]); w.y = cvt_pk_bf16(v0[2], v0[3]); w.z = cvt_pk_bf16(v1[0], v1[1]); w.w = cvt_pk_bf16(v1[2], v1[3]);
                    *(u32x4*)(rowp + bj * HALF) = w; } }
    }
};
struct EpiF32 {
    static constexpr bool PERM = false, AFTER_DRAIN = false;
    float* C; int ldc;
    __device__ __forceinline__ void operator()(const f32x4 (&acc)[2][2][4][2], const Unit& u, int wr, int wc, int fr, int fq) const {
        const int row0 = u.pm * BM + wr * 64 + fr, col0 = u.pn * BM + wc * 32 + 4 * fq;
#pragma unroll
        for (int ai = 0; ai < 2; ++ai)
#pragma unroll
            for (int m = 0; m < 4; ++m) { float* rowp = C + (size_t)(row0 + ai * HALF + m * 16) * ldc + col0;
#pragma unroll
                for (int bj = 0; bj < 2; ++bj)
#pragma unroll
                    for (int n = 0; n < 2; ++n) *(f32x4*)(rowp + bj * HALF + n * 16) = acc[ai][bj][m][n]; }
    }
};
template <class Epi, class Sched, bool ALIGN_EPI = false, bool SP2 = false>
__device__ __forceinline__ void gemm_phase(PG8_LAS unsigned char* lds, const Gemm g, const Sched& S, const Epi& E) {
    const int tid = fresh_tid(), wid = __builtin_amdgcn_readfirstlane(tid >> 6), lane = tid & 63, wr = wid >> 2, wc = wid & 3, fr = lane & 15, fq = lane >> 4;
    const int K = g.K, nt = K / BK;
    unsigned voffA[2], voffB[2];
#pragma unroll
    for (int i = 0; i < 2; ++i) { int R, C; stage_rc(tid * 16 + i * 8192, R, C); const int Rb = Epi::PERM ? ((R & ~31) + perm32(R & 31)) : R;
        voffA[i] = (unsigned)(R * K + C) * 2u; voffB[i] = (unsigned)(Rb * K + C) * 2u; }
    const size_t kstep = (size_t)(BK * 2);
    const size_t hstep = (size_t)HALF * K * 2;
    const size_t tstep = 2 * hstep;
    const unsigned ldsw = (unsigned)wid * 1024u;
    const int aoff = lds_byte(wr * 64 + fr, fq * 8), boff = lds_byte(wc * 32 + fr, fq * 8);
#define PG8_SA(b, h) (((b) * 2 + (h)) * HTB)
#define PG8_SB(b, h) ((4 + (b) * 2 + (h)) * HTB)
#define PG8_STAGE(bufoff, gbase, voff) do { _Pragma("unroll") for (int _i = 0; _i < 2; ++_i) \
        __builtin_amdgcn_global_load_lds((const unsigned*)((const char*)(gbase) + (voff)[_i]), (PG8_LAS unsigned*)(lds + (bufoff) + ldsw + _i * 8192), 16, 0, 0); } while (0)
#define PG8_LDA(dst, b, h) do { _Pragma("unroll") for (int m = 0; m < 4; ++m) _Pragma("unroll") for (int k = 0; k < 2; ++k) dst[m][k] = *(const PG8_LAS bf16x8*)(lds + PG8_SA(b, h) + aoff + m * 2048 + k * 1024); } while (0)
#define PG8_LDB(dst, b, h) do { _Pragma("unroll") for (int n = 0; n < 2; ++n) _Pragma("unroll") for (int k = 0; k < 2; ++k) dst[n][k] = *(const PG8_LAS bf16x8*)(lds + PG8_SB(b, h) + boff + n * 2048 + k * 1024); } while (0)
#define PG8_MMA(ai, bj, At, Bt) do { __builtin_amdgcn_s_setprio(1); _Pragma("unroll") for (int m = 0; m < 4; ++m) _Pragma("unroll") for (int n = 0; n < 2; ++n) _Pragma("unroll") for (int k = 0; k < 2; ++k) \
        acc[ai][bj][m][n] = __builtin_amdgcn_mfma_f32_16x16x32_bf16(Bt[n][k], At[m][k], acc[ai][bj][m][n], 0, 0, 0); __builtin_amdgcn_s_setprio(0); } while (0)
#define PG8_WAIT_V(n) asm volatile("s_waitcnt vmcnt(" #n ")" ::: "memory")
#define PG8_WAIT_L(n) asm volatile("s_waitcnt lgkmcnt(" #n ")" ::: "memory")
#define PG8_BAR __builtin_amdgcn_s_barrier()
#define PG8_SCHED __builtin_amdgcn_sched_barrier(0)
    Unit cur, nxt; int ui = 0;
    if (!S.next(0, cur)) return;
    f32x4 acc[2][2][4][2];
#pragma unroll
    for (int a = 0; a < 2; ++a)
#pragma unroll
        for (int b = 0; b < 2; ++b)
#pragma unroll
            for (int m = 0; m < 4; ++m)
#pragma unroll
                for (int n = 0; n < 2; ++n) acc[a][b][m][n] = (f32x4){0.f, 0.f, 0.f, 0.f};
    bf16x8 At[4][2], B0[2][2], B1[2][2];
    const char* cA = (const char*)g.A + (size_t)cur.pm * tstep; const char* cB = (const char*)g.Bt + (size_t)cur.pn * tstep;
    S.a_ready(cur);
    if constexpr (SP2) {
        PG8_STAGE(PG8_SB(0, 0), cB, voffB); PG8_STAGE(PG8_SB(0, 1), cB + hstep, voffB); PG8_STAGE(PG8_SA(0, 0), cA, voffA); PG8_STAGE(PG8_SA(0, 1), cA + hstep, voffA);
        if (wr == 1) PG8_BAR;
        PG8_WAIT_V(2); PG8_BAR;
        PG8_STAGE(PG8_SB(1, 0), cB + kstep, voffB); PG8_STAGE(PG8_SA(1, 0), cA + kstep, voffA); PG8_STAGE(PG8_SB(1, 1), cB + hstep + kstep, voffB);
        PG8_WAIT_V(6); PG8_BAR;
    } else {
        PG8_STAGE(PG8_SB(0, 0), cB, voffB); PG8_STAGE(PG8_SA(0, 0), cA, voffA); PG8_STAGE(PG8_SB(0, 1), cB + hstep, voffB); PG8_STAGE(PG8_SA(0, 1), cA + hstep, voffA);
        if (wr == 1) PG8_BAR;
        PG8_WAIT_V(4); PG8_BAR;
        PG8_STAGE(PG8_SB(1, 0), cB + kstep, voffB); PG8_STAGE(PG8_SA(1, 0), cA + kstep, voffA); PG8_STAGE(PG8_SB(1, 1), cB + hstep + kstep, voffB);
        PG8_WAIT_V(6); PG8_BAR;
    }
    for (;;) {
        const bool has_next = S.next(ui + 1, nxt);
        const char* nA = has_next ? (const char*)g.A + (size_t)nxt.pm * tstep : cA; const char* nB = has_next ? (const char*)g.Bt + (size_t)nxt.pn * tstep : cB;
        for (int t = 0; t < nt; t += 2) {
            const bool last = (t == nt - 2);
            const char* a1 = cA + (size_t)(t + 1) * kstep;
            const char* a2 = last ? nA : cA + (size_t)(t + 2) * kstep; const char* b2 = last ? nB : cB + (size_t)(t + 2) * kstep;
            const char* a3 = a2 + kstep; const char* b3 = b2 + kstep;
            if (last && has_next) S.a_ready(nxt);
            if constexpr (SP2) {
            PG8_LDB(B0, 0, 0); PG8_LDB(B1, 0, 1); PG8_SCHED; PG8_LDA(At, 0, 0); PG8_STAGE(PG8_SA(1, 1), a1 + hstep, voffA);
            PG8_WAIT_V(8); PG8_WAIT_L(0); PG8_BAR; PG8_MMA(0, 0, At, B0); PG8_MMA(0, 1, At, B1); PG8_BAR; PG8_SCHED;
            PG8_LDA(At, 0, 1); PG8_STAGE(PG8_SB(0, 0), b2, voffB); PG8_STAGE(PG8_SB(0, 1), b2 + hstep, voffB); PG8_STAGE(PG8_SA(0, 0), a2, voffA);
            PG8_WAIT_V(8); PG8_WAIT_L(0); PG8_BAR; PG8_MMA(1, 0, At, B0); PG8_MMA(1, 1, At, B1); PG8_BAR; PG8_SCHED;
            PG8_LDB(B0, 1, 0); PG8_LDB(B1, 1, 1); PG8_SCHED; PG8_LDA(At, 1, 0); PG8_STAGE(PG8_SA(0, 1), a2 + hstep, voffA);
            PG8_WAIT_V(8); PG8_WAIT_L(0); PG8_BAR; PG8_MMA(0, 0, At, B0); PG8_MMA(0, 1, At, B1); PG8_BAR; PG8_SCHED;
            PG8_LDA(At, 1, 1); PG8_STAGE(PG8_SB(1, 0), b3, voffB); PG8_STAGE(PG8_SB(1, 1), b3 + hstep, voffB); PG8_STAGE(PG8_SA(1, 0), a3, voffA);
            PG8_WAIT_V(8); PG8_WAIT_L(0); PG8_BAR; PG8_MMA(1, 0, At, B0); PG8_MMA(1, 1, At, B1); PG8_BAR; PG8_SCHED;
            } else {
            PG8_LDB(B0, 0, 0); PG8_SCHED; PG8_LDA(At, 0, 0); PG8_STAGE(PG8_SA(1, 1), a1 + hstep, voffA);
            PG8_WAIT_L(8); PG8_BAR; PG8_WAIT_L(0); PG8_MMA(0, 0, At, B0); PG8_BAR; PG8_SCHED;
            PG8_LDB(B1, 0, 1); PG8_STAGE(PG8_SB(0, 0), b2, voffB);
            PG8_BAR; PG8_WAIT_L(0); PG8_MMA(0, 1, At, B1); PG8_BAR;
            PG8_LDA(At, 0, 1); PG8_STAGE(PG8_SA(0, 0), a2, voffA);
            PG8_BAR; PG8_WAIT_L(0); PG8_MMA(1, 0, At, B0); PG8_BAR; PG8_SCHED;
            PG8_STAGE(PG8_SB(0, 1), b2 + hstep, voffB);
            PG8_WAIT_V(6); PG8_BAR; PG8_MMA(1, 1, At, B1); PG8_BAR;
            PG8_LDB(B0, 1, 0); PG8_SCHED; PG8_LDA(At, 1, 0); PG8_STAGE(PG8_SA(0, 1), a2 + hstep, voffA);
            PG8_WAIT_L(8); PG8_BAR; PG8_WAIT_L(0); PG8_MMA(0, 0, At, B0); PG8_BAR; PG8_SCHED;
            PG8_LDB(B1, 1, 1); PG8_STAGE(PG8_SB(1, 0), b3, voffB);
            PG8_BAR; PG8_WAIT_L(0); PG8_MMA(0, 1, At, B1); PG8_BAR;
            PG8_LDA(At, 1, 1); PG8_STAGE(PG8_SA(1, 0), a3, voffA);
            PG8_BAR; PG8_WAIT_L(0); PG8_MMA(1, 0, At, B0); PG8_BAR; PG8_SCHED;
            PG8_STAGE(PG8_SB(1, 1), b3 + hstep, voffB);
            PG8_WAIT_V(6); PG8_BAR; PG8_MMA(1, 1, At, B1); PG8_BAR;
            }
        }
        if constexpr (ALIGN_EPI) { if (wr == 0) PG8_BAR; }
        if constexpr (!Epi::AFTER_DRAIN) { E(acc, cur, wr, wc, fr, fq); S.done(cur); }
        if (!has_next) break;
#pragma unroll
        for (int a = 0; a < 2; ++a)
#pragma unroll
            for (int b = 0; b < 2; ++b)
#pragma unroll
                for (int m = 0; m < 4; ++m)
#pragma unroll
                    for (int n = 0; n < 2; ++n) acc[a][b][m][n] = (f32x4){0.f, 0.f, 0.f, 0.f};
        cur = nxt; cA = nA; cB = nB; ++ui;
        if constexpr (ALIGN_EPI) { if (wr == 1) PG8_BAR; }
    }
    PG8_WAIT_V(0);
    if constexpr (!ALIGN_EPI) { if (wr == 0) PG8_BAR; }
    PG8_BAR;
    if constexpr (Epi::AFTER_DRAIN) { E.fused(acc, cur, wr, wc, fr, fq, lds, wid, lane); S.done(cur); }
#undef PG8_SA
#undef PG8_SB
#undef PG8_STAGE
#undef PG8_LDA
#undef PG8_LDB
#undef PG8_MMA
#undef PG8_WAIT_V
#undef PG8_WAIT_L
#undef PG8_BAR
#undef PG8_SCHED
}
}
typedef unsigned short bf16;
constexpr int S_ = 8192, DM = 2048, DIN = 6656, DF = 512, DD = 1024, DG = 512, NH = 8, DEPTH = 2;
constexpr int OFF_AIN = 0, OFF_AG = 512, OFF_Q = 1024, OFF_K = 2048, OFF_V = 3072, OFF_BG = 4096, OFF_U = 5120, OFF_VS = 5632, OFF_CG = 6144;
constexpr float EPS = 1e-6f;
constexpr float LAMBDA_INIT0 = 0.2f;
constexpr float LAMBDA_INIT1 = 0.35550906759f;
__host__ __device__ __forceinline__ float lambda_init(int l) { return l == 0 ? LAMBDA_INIT0 : LAMBDA_INIT1; }

__device__ __forceinline__ unsigned f2bf(float f) { unsigned u = __builtin_bit_cast(unsigned, f); return (u + 0x7fffu + ((u >> 16) & 1u)) >> 16; }
__device__ __forceinline__ float bf2f(unsigned short b) { return __builtin_bit_cast(float, (unsigned)b << 16); }
__device__ __forceinline__ float wave_sum(float v) {
#pragma unroll
    for (int o = 1; o < 64; o <<= 1) v += __shfl_xor(v, o);
    return v;
}
__device__ __forceinline__ float wave_max(float v) {
#pragma unroll
    for (int o = 1; o < 64; o <<= 1) v = fmaxf(v, __shfl_xor(v, o));
    return v;
}
__device__ __forceinline__ float silu(float x) { return x / (1.f + __expf(-x)); }

constexpr size_t MiB = 1u << 20;
constexpr size_t WS_CTL = 0;
constexpr size_t WS_TAB = 64 * 1024;
constexpr size_t WS_BIAS = 192 * 1024;
constexpr size_t WS_LAM = 256 * 1024;
constexpr size_t WS_RSTDSG = 512 * 1024;
constexpr size_t WS_FM = 640 * 1024;
constexpr size_t WS_GM = 704 * 1024;
constexpr size_t WS_WINT = 1 * MiB;
constexpr size_t WS_WOUTT = 54 * MiB;
constexpr size_t WS_WF2T = 70 * MiB;
constexpr size_t WS_XN = 72 * MiB;
constexpr size_t WS_PROJ = 104 * MiB;
constexpr size_t WS_TP = 208 * MiB;
constexpr size_t WS_X2 = 224 * MiB;
constexpr size_t WS_Y = 240 * MiB;
constexpr size_t WS_YOUT = 272 * MiB;
constexpr size_t WS_END = 336 * MiB;

#define LAS __attribute__((address_space(3)))
#define GAS __attribute__((address_space(1)))
typedef unsigned v4u __attribute__((ext_vector_type(4)));
constexpr int NTHR = 512, NWAVES = 8;
constexpr int LDS_BYTES = 147456;
#define LDS_WAIT() asm volatile("s_waitcnt lgkmcnt(0)" ::: "memory")
__device__ __forceinline__ unsigned pk2(float lo, float hi) { return f2bf(lo) | (f2bf(hi) << 16); }

__device__ __forceinline__ void p0_transpose_item(const float* W, int K, int N, bf16* WT, LAS float* scr, int item, int lane) {
    const int nblk = N / 32, kb = item / nblk, nb = item % nblk, k0 = 64 * kb, n0 = 32 * nb;
#pragma unroll 8
    for (int i = 0; i < 32; ++i) { const int kk = 2 * i + (lane >> 5); scr[kk * 33 + (lane & 31)] = W[(size_t)(k0 + kk) * N + n0 + (lane & 31)]; }
    LDS_WAIT(); asm volatile("" ::: "memory");
    const int c = lane & 7;
#pragma unroll
    for (int j = 0; j < 4; ++j) { const int n = (lane >> 3) + 8 * j; const LAS float* s = scr + (8 * c) * 33 + n;
        v4u o; o.x = pk2(s[0 * 33], s[1 * 33]); o.y = pk2(s[2 * 33], s[3 * 33]); o.z = pk2(s[4 * 33], s[5 * 33]); o.w = pk2(s[6 * 33], s[7 * 33]);
        *(v4u*)(WT + (size_t)(n0 + n) * K + k0 + 8 * c) = o; }
    LDS_WAIT(); asm volatile("" ::: "memory");
}
__device__ __forceinline__ void rms_row_to_bf16(const float4 (&v)[8], const float* gain, bf16* xnrow, int lane) {
    float ss = 0.f;
#pragma unroll
    for (int j = 0; j < 8; ++j) ss += v[j].x * v[j].x + v[j].y * v[j].y + v[j].z * v[j].z + v[j].w * v[j].w;
    const float rstd = rsqrtf(wave_sum(ss) * (1.f / DM) + EPS);
    const float4* gr = (const float4*)gain + lane; uint2* o = (uint2*)xnrow + lane;
#pragma unroll
    for (int j = 0; j < 8; ++j) { const float4 g = gr[64 * j];
        o[64 * j] = make_uint2(pk2(v[j].x * rstd * g.x, v[j].y * rstd * g.y), pk2(v[j].z * rstd * g.z, v[j].w * rstd * g.w)); }
}
#define GTID ((int)(blockIdx.x * NTHR) + fresh_tid())
#define GSIZE ((int)(gridDim.x * NTHR))
#define GWAVE ((int)(blockIdx.x * NWAVES) + (fresh_tid() >> 6))
#define GNWAVES ((int)(gridDim.x * NWAVES))
__device__ __forceinline__ int t5_bucket(int rel) {
    const int ret = rel > 0 ? 16 : 0; const int n = rel < 0 ? -rel : rel;
    if (n < 8) return ret + n;
    int j = 0; while (j < 7 && (64 << (j + 1)) <= n * n) ++j;
    return ret + 8 + j;
}
__device__ __forceinline__ void ph_wf2(const float* __restrict__ wf, bf16* __restrict__ Wf2T) {
    for (int idx = GTID; idx < 512 * 1024; idx += GSIZE) {
        const int j = idx >> 10, pc = idx & 1023, part = pc >> 9, c = pc & 511, g = c >> 7, n3 = c & 127;
        float acc = 0.f;
        for (int k3 = 0; k3 < 128; ++k3) { const int a = (k3 * n3) & 127; float sn, cs; sincospif((float)a * (1.f / 64.f), &sn, &cs);
            acc += (part ? sn : cs) * wf[(size_t)(g * 128 + k3) * 512 + j]; }
        Wf2T[idx] = (bf16)f2bf(acc * 9.765625e-4f); }
}
__device__ __forceinline__ void ph_tables(const float* __restrict__ rel_bias, const float* __restrict__ lambda_qk, float2* __restrict__ trig, float* __restrict__ biasTab, float* __restrict__ biasTab8, float* __restrict__ lam, bf16* __restrict__ Fm, bf16* __restrict__ Gm) {
    for (int idx = GTID; idx < 32768; idx += GSIZE) {
        { const int row = idx >> 7, n1 = idx & 127, w = row >> 5, i = row & 31, k1 = 16 * w + (i & 7) + 8 * (i >> 4), part = (i >> 3) & 1; float sn, cs; sincospif((float)((n1 * k1) & 127) * (1.f / 64.f), &sn, &cs); Fm[idx] = (bf16)f2bf(part ? -sn : cs); }
        if (idx < 16384) { const int row = idx >> 7, k = idx & 127, wq = row >> 5, i = row & 31, k2 = 16 * wq + (i & 7) + 8 * (i >> 4), pout = (i >> 3) & 1, n2 = k >> 1, pin = k & 1; float sn, cs; sincospif((float)((n2 * k2) & 63) * (1.f / 32.f), &sn, &cs); Gm[idx] = (bf16)f2bf(pout == pin ? cs : (pout == 0 ? sn : -sn)); }
        if (idx < 8192) { float sn, cs; sincospif((float)idx * (1.f / 4096.f), &sn, &cs); trig[idx] = make_float2(cs, sn); }
        if (idx < 8 * 272) { const int h = idx / 272, i = idx % 272; int rel = i - 128; if (rel > 128) rel = 128; const float bv = rel_bias[t5_bucket(rel) * 8 + h]; biasTab[idx] = bv; }
        if (idx < 8 * 512) { const int h = idx >> 9; int rel = (idx & 511) - 256; rel = rel < -128 ? -128 : (rel > 128 ? 128 : rel); biasTab8[idx] = 8.f * rel_bias[t5_bucket(rel) * 8 + h]; }
        if (idx < 2) { const float* lq = lambda_qk + idx * 256; float a = 0.f, b = 0.f; for (int i = 0; i < 64; ++i) { a += lq[i] * lq[64 + i]; b += lq[128 + i] * lq[192 + i]; }
            lam[idx] = expf(a) - expf(b) + lambda_init(idx); } }
}
__device__ __forceinline__ void ph_f1_naive(const bf16* __restrict__ proj, const float2* __restrict__ trig, bf16* __restrict__ Tp) {
    for (int idx = GTID; idx < 128 * 64 * 512; idx += GSIZE) { const int c = idx & 511, n2 = (idx >> 9) & 63, k1 = idx >> 15;
        float tr = 0.f, ti = 0.f;
        for (int n1 = 0; n1 < 128; ++n1) { const float a = bf2f(proj[(size_t)(64 * n1 + n2) * DIN + OFF_AIN + c]); const float2 cs = trig[((n1 * k1) & 127) * 64]; tr += a * cs.x; ti -= a * cs.y; }
        const float2 tw = trig[k1 * n2];
        const float pr = tr * tw.x + ti * tw.y, pi = ti * tw.x - tr * tw.y;
        Tp[((size_t)(k1 * 64 + n2) * 2 + 0) * 512 + c] = (bf16)f2bf(pr); Tp[((size_t)(k1 * 64 + n2) * 2 + 1) * 512 + c] = (bf16)f2bf(pi); }
}
__device__ __forceinline__ void ph_f2_naive(const bf16* __restrict__ Tp, const float2* __restrict__ trig, bf16* __restrict__ X2) {
    for (int idx = GTID; idx < 128 * 64 * 512; idx += GSIZE) { const int c = idx & 511, k2 = (idx >> 9) & 63, k1 = idx >> 15;
        float xr = 0.f, xi = 0.f;
        for (int n2 = 0; n2 < 64; ++n2) { const float tr = bf2f(Tp[((size_t)(k1 * 64 + n2) * 2 + 0) * 512 + c]), ti = bf2f(Tp[((size_t)(k1 * 64 + n2) * 2 + 1) * 512 + c]);
            const float2 cs = trig[((n2 * k2) & 63) * 128]; xr += tr * cs.x + ti * cs.y; xi += ti * cs.x - tr * cs.y; }
        X2[(size_t)(k1 * 64 + k2) * 1024 + c] = (bf16)f2bf(xr); X2[(size_t)(k1 * 64 + k2) * 1024 + 512 + c] = (bf16)f2bf(xi); }
}
__device__ __forceinline__ void ph_ya_naive(const bf16* __restrict__ X2, const bf16* __restrict__ Wf2T, const bf16* __restrict__ proj, bf16* __restrict__ Y) {
    for (int idx = GTID; idx < 8192 * 512; idx += GSIZE) { const int j = idx & 511, rho = idx >> 9, k1 = rho >> 6, k2 = rho & 63, row = k1 + 128 * k2;
        float acc = 0.f;
        for (int pc = 0; pc < 1024; ++pc) acc += bf2f(X2[(size_t)rho * 1024 + pc]) * bf2f(Wf2T[(size_t)j * 1024 + pc]);
        Y[(size_t)row * DM + j] = (bf16)f2bf(acc * silu(bf2f(proj[(size_t)row * DIN + OFF_AG + j]))); }
}
__device__ __forceinline__ void ph_sgu_rstd(const bf16* __restrict__ proj, float* __restrict__ rstd_sg) {
    for (int idx = GTID; idx < 8192 * 4; idx += GSIZE) { const int g = idx & 3, pos = idx >> 2;
        float ss = 0.f; for (int c = 0; c < 128; ++c) { const float v = bf2f(proj[(size_t)pos * DIN + OFF_VS + g * 128 + c]); ss += v * v; }
        rstd_sg[idx] = rsqrtf(ss * (1.f / 128.f) + EPS); }
}
__device__ __forceinline__ void ph_sgu_naive(const bf16* __restrict__ proj, const float* __restrict__ rstd_sg, const float* __restrict__ vgain, const float* __restrict__ ws, const float* __restrict__ bs, bf16* __restrict__ Y) {
    for (int idx = GTID; idx < 8192 * 512; idx += GSIZE) { const int gc = idx & 511, p = idx >> 9, g = gc >> 7, pp = p & 127, ch = p >> 7;
        float acc = 0.f; const float gn = vgain[gc];
        for (int q = 0; q < 128; ++q) { const int pos = ch * 128 + q; acc += ws[(size_t)(g * 128 + pp) * 128 + q] * (bf2f(proj[(size_t)pos * DIN + OFF_VS + gc]) * rstd_sg[pos * 4 + g] * gn); }
        const float mixed = acc + bs[g * 128 + pp];
        const float u = bf2f(proj[(size_t)p * DIN + OFF_U + gc]);
        Y[(size_t)p * DM + 1536 + gc] = (bf16)f2bf(u * mixed * silu(bf2f(proj[(size_t)p * DIN + OFF_CG + gc]))); }
}
__device__ __forceinline__ void ph_attn_naive(const bf16* __restrict__ proj, const float* __restrict__ biasTab, const float* __restrict__ lamp, const float* __restrict__ ogain, int layer, bf16* __restrict__ Y) {
  const int lane = fresh_tid() & 63;
  for (int w = GWAVE; w < NH * S_; w += GNWAVES) { const int h = w >> 13, q = w & 8191;
    float qv[128];
    { const bf16* qp = proj + (size_t)q * DIN + OFF_Q + h * 128;
#pragma unroll
      for (int d = 0; d < 128; ++d) qv[d] = bf2f(qp[d]) * 0.125f; }
    const float* bt = biasTab + h * 272 + 128;
    float m0 = -1e30f, m1 = -1e30f, l0 = 0.f, l1 = 0.f;
    for (int t = 0; t < 128; ++t) { const int k = t * 64 + lane; const uint4* kp = (const uint4*)(proj + (size_t)k * DIN + OFF_K + h * 128);
        float s0 = 0.f, s1 = 0.f;
#pragma unroll
        for (int i = 0; i < 16; ++i) { const uint4 kk = kp[i]; const unsigned wv[4] = {kk.x, kk.y, kk.z, kk.w};
#pragma unroll
            for (int e = 0; e < 4; ++e) { const float a = __builtin_bit_cast(float, wv[e] << 16), b = __builtin_bit_cast(float, wv[e] & 0xffff0000u);
                if (i < 8) s0 += qv[i * 8 + e * 2] * a + qv[i * 8 + e * 2 + 1] * b; else s1 += qv[i * 8 + e * 2] * a + qv[i * 8 + e * 2 + 1] * b; } }
        int rel = k - q; rel = rel < -128 ? -128 : (rel > 128 ? 128 : rel); const float b = bt[rel]; s0 += b; s1 += b;
        { const float mn = fmaxf(m0, s0); l0 = l0 * __expf(m0 - mn) + __expf(s0 - mn); m0 = mn; }
        { const float mn = fmaxf(m1, s1); l1 = l1 * __expf(m1 - mn) + __expf(s1 - mn); m1 = mn; } }
    { const float M0 = wave_max(m0), M1 = wave_max(m1); l0 = wave_sum(l0 * __expf(m0 - M0)); l1 = wave_sum(l1 * __expf(m1 - M1)); m0 = M0; m1 = M1; }
    const float lam = lamp[layer], il0 = 1.f / l0, il1 = lam / l1;
    float acc0 = 0.f, acc1 = 0.f;
    for (int t = 0; t < 128; ++t) { const int k = t * 64 + lane; const uint4* kp = (const uint4*)(proj + (size_t)k * DIN + OFF_K + h * 128);
        float s0 = 0.f, s1 = 0.f;
#pragma unroll
        for (int i = 0; i < 16; ++i) { const uint4 kk = kp[i]; const unsigned wv[4] = {kk.x, kk.y, kk.z, kk.w};
#pragma unroll
            for (int e = 0; e < 4; ++e) { const float a = __builtin_bit_cast(float, wv[e] << 16), b = __builtin_bit_cast(float, wv[e] & 0xffff0000u);
                if (i < 8) s0 += qv[i * 8 + e * 2] * a + qv[i * 8 + e * 2 + 1] * b; else s1 += qv[i * 8 + e * 2] * a + qv[i * 8 + e * 2 + 1] * b; } }
        int rel = k - q; rel = rel < -128 ? -128 : (rel > 128 ? 128 : rel); const float b = bt[rel]; s0 += b; s1 += b;
        const float wgt = __expf(s0 - m0) * il0 - __expf(s1 - m1) * il1;
        const unsigned* vp = (const unsigned*)(proj + (size_t)(t * 64) * DIN + OFF_V + h * 128) + lane;
        for (int kk = 0; kk < 64; ++kk) { const float wk = __shfl(wgt, kk); const unsigned vv = vp[(size_t)kk * (DIN / 2)];
            acc0 += wk * __builtin_bit_cast(float, vv << 16); acc1 += wk * __builtin_bit_cast(float, vv & 0xffff0000u); } }
    const float rstd = rsqrtf(wave_sum(acc0 * acc0 + acc1 * acc1) * (1.f / 128.f) + EPS) * (1.f - lambda_init(layer));
    const int col = h * 128 + 2 * lane;
    const float y0 = acc0 * rstd * ogain[col] * silu(bf2f(proj[(size_t)q * DIN + OFF_BG + col]));
    const float y1 = acc1 * rstd * ogain[col + 1] * silu(bf2f(proj[(size_t)q * DIN + OFF_BG + col + 1]));
    *(unsigned*)(Y + (size_t)q * DM + 512 + col) = f2bf(y0) | (f2bf(y1) << 16);
  }
}
namespace dattn {
using bf16x8 = __attribute__((ext_vector_type(8))) short;
using s16x4  = __attribute__((ext_vector_type(4))) short;
using f32x16 = __attribute__((ext_vector_type(16))) float;
using u32x4  = __attribute__((ext_vector_type(4))) unsigned;
using f32x4v = __attribute__((ext_vector_type(4))) float;
constexpr int QBLK = 32, KVBLK = 64;
constexpr float SCALE = 0.125f, THR = 8.f;
#ifndef DATTN_SDEPTH
#define DATTN_SDEPTH 1
#endif
constexpr int SDEPTH = DATTN_SDEPTH;
constexpr size_t SHM_V = KVBLK * 128 * 2, SHM_K = KVBLK * 128 * 2, SHM_ATTN = 2 * SHM_V + 2 * SHM_K + 8 * 64 * 4;
#define KSWZ(row, colB) ((row) * 256 + ((colB) ^ (((row) & 7) << 4)))
#define SBAR() __builtin_amdgcn_sched_barrier(0)
__device__ __forceinline__ int crow(int r, int hi) { return (r & 3) + 8 * (r >> 2) + 4 * hi; }
__device__ __forceinline__ unsigned cvtpk(float lo, float hi) { unsigned r; asm volatile("v_cvt_pk_bf16_f32 %0, %1, %2" : "=v"(r) : "v"(lo), "v"(hi)); return r; }
__device__ __forceinline__ void partialSM(f32x16& p0, f32x16& p1, float& m_reg, float& mn, float& alpha) {
  constexpr float C = SCALE * 1.4426950408889634f;
  float pmax = p0[0]; for (int r = 1; r < 16; ++r) pmax = fmaxf(pmax, p0[r]); for (int r = 0; r < 16; ++r) pmax = fmaxf(pmax, p1[r]);
  { auto rr = __builtin_amdgcn_permlane32_swap(__float_as_uint(pmax), __float_as_uint(pmax), false, false);
    pmax = fmaxf(__uint_as_float(rr[0]), __uint_as_float(rr[1])); }
  if (__builtin_expect(__all(pmax - m_reg <= THR / SCALE), 1)) { mn = m_reg; alpha = 1.f; }
  else { mn = fmaxf(m_reg, pmax); alpha = __builtin_amdgcn_exp2f((m_reg - mn) * C); m_reg = mn; }
  float mnC = -mn * C;
  for (int r = 0; r < 16; ++r) p0[r] = fmaf(p0[r], C, mnC); for (int r = 0; r < 16; ++r) p1[r] = fmaf(p1[r], C, mnC);
  for (int r = 0; r < 16; ++r) p0[r] = __builtin_amdgcn_exp2f(p0[r]);
}
__device__ __forceinline__ void finishSM(f32x16& p0, f32x16& p1, float alpha, float& l_reg, bf16x8& pa0, bf16x8& pa1, bf16x8& pa2, bf16x8& pa3) {
  for (int r = 0; r < 16; ++r) p1[r] = __builtin_amdgcn_exp2f(p1[r]);
  float ps = 0; for (int r = 0; r < 16; ++r) ps += p0[r]; for (int r = 0; r < 16; ++r) ps += p1[r];
  { auto rr = __builtin_amdgcn_permlane32_swap(__float_as_uint(ps), __float_as_uint(ps), false, false);
    ps = __uint_as_float(rr[0]) + __uint_as_float(rr[1]); }
  l_reg = l_reg * alpha + ps;
#define PK4(P, BASE, OUT) do { unsigned a0 = cvtpk(P[BASE + 0], P[BASE + 1]), a1 = cvtpk(P[BASE + 2], P[BASE + 3]);   \
    unsigned b0 = cvtpk(P[BASE + 4], P[BASE + 5]), b1 = cvtpk(P[BASE + 6], P[BASE + 7]);                              \
    auto r0 = __builtin_amdgcn_permlane32_swap(a0, b0, false, false); auto r1 = __builtin_amdgcn_permlane32_swap(a1, b1, false, false); \
    u32x4 w = {r0[0], r1[0], r0[1], r1[1]}; OUT = *reinterpret_cast<bf16x8*>(&w); } while (0)
  PK4(p0, 0, pa0); PK4(p0, 8, pa1); PK4(p1, 0, pa2); PK4(p1, 8, pa3);
#undef PK4
}
__device__ __forceinline__ void qkt(f32x16& p0, f32x16& p1, const bf16* Ks, const bf16x8* qr, int r32, int hi, int cbase) {
#pragma unroll
  for (int d0 = 0; d0 < 4; ++d0) { int cb = (cbase + d0 * 16 + hi * 8) * 2;
    bf16x8 b0 = *reinterpret_cast<const bf16x8*>((const char*)Ks + KSWZ(r32, cb));
    bf16x8 b1 = *reinterpret_cast<const bf16x8*>((const char*)Ks + KSWZ(32 + r32, cb));
    p0 = __builtin_amdgcn_mfma_f32_32x32x16_bf16(b0, qr[d0], p0, 0, 0, 0);
    p1 = __builtin_amdgcn_mfma_f32_32x32x16_bf16(b1, qr[d0], p1, 0, 0, 0); }
}
__device__ __forceinline__ int v_st(int k, int c) { const int kk = (k & ~0xC) | ((k & 4) << 1) | ((k & 8) >> 1); return ((kk >> 3) * 4 + (c >> 5)) * 512 + ((kk & 7) * 32 + (c & 31)) * 2; }
__device__ __forceinline__ int v_rd_base(int lane) { return ((lane & 3) << 3) | (((lane >> 2) & 3) << 6) | (((lane >> 4) & 1) << 5) | (((lane >> 5) & 1) << 8); }
constexpr int v_rd_off(int d0, int ks, int half) { return d0 * 512 + ks * 4096 + half * 2048; }
template <int OFF> __device__ __forceinline__ s16x4 tr_read(int vb) {
  s16x4 r; asm volatile("ds_read_b64_tr_b16 %0, %1 offset:%2" : "=&v"(r) : "v"(vb), "i"(OFF) : "memory"); return r;
}
template <int D0> __device__ __forceinline__ void pv_one(f32x16& od, int vb, bf16x8 pa0, bf16x8 pa1, bf16x8 pa2, bf16x8 pa3) {
  const s16x4 l0 = tr_read<v_rd_off(D0, 0, 0)>(vb), h0 = tr_read<v_rd_off(D0, 0, 1)>(vb), l1 = tr_read<v_rd_off(D0, 1, 0)>(vb), h1 = tr_read<v_rd_off(D0, 1, 1)>(vb);
  const s16x4 l2 = tr_read<v_rd_off(D0, 2, 0)>(vb), h2 = tr_read<v_rd_off(D0, 2, 1)>(vb), l3 = tr_read<v_rd_off(D0, 3, 0)>(vb), h3 = tr_read<v_rd_off(D0, 3, 1)>(vb);
  asm volatile("s_waitcnt lgkmcnt(0)" ::: "memory"); SBAR();
#define PK(L, H) (bf16x8){L[0], L[1], L[2], L[3], H[0], H[1], H[2], H[3]}
  od = __builtin_amdgcn_mfma_f32_32x32x16_bf16(pa0, PK(l0, h0), od, 0, 0, 0);
  od = __builtin_amdgcn_mfma_f32_32x32x16_bf16(pa1, PK(l1, h1), od, 0, 0, 0);
  od = __builtin_amdgcn_mfma_f32_32x32x16_bf16(pa2, PK(l2, h2), od, 0, 0, 0);
  od = __builtin_amdgcn_mfma_f32_32x32x16_bf16(pa3, PK(l3, h3), od, 0, 0, 0);
#undef PK
}
__device__ __forceinline__ void pv_d0(f32x16* o, int vb, bf16x8 pa0, bf16x8 pa1, bf16x8 pa2, bf16x8 pa3) {
  pv_one<0>(o[0], vb, pa0, pa1, pa2, pa3); pv_one<1>(o[1], vb, pa0, pa1, pa2, pa3); pv_one<2>(o[2], vb, pa0, pa1, pa2, pa3); pv_one<3>(o[3], vb, pa0, pa1, pa2, pa3);
}
__device__ __forceinline__ void bias_init(f32x16& p0, f32x16& p1, int k0, int qwave, int qpos, const float* btl, float bL, float bR, int hi) {
  if (k0 + 63 - qwave <= -128) { for (int r = 0; r < 16; ++r) { p0[r] = bL; p1[r] = bL; } }
  else if (k0 - qwave - 31 >= 128) { for (int r = 0; r < 16; ++r) { p0[r] = bR; p1[r] = bR; } }
  else { const float* b = btl + (256 + k0 - qpos + 4 * hi);
#pragma unroll
    for (int r = 0; r < 16; ++r) { p0[r] = b[(r & 3) + 8 * (r >> 2)]; p1[r] = b[(r & 3) + 8 * (r >> 2) + 32]; }
  }
}

__device__ __forceinline__ void dattn_unit(int h, int qb, const bf16* __restrict__ proj, const float* __restrict__ bt8, float lam, float oscale, const float* __restrict__ ogain, bf16* __restrict__ Y, char* lds) {
  const int tid = fresh_tid(), wid = tid >> 6, lane = tid & 63, r32 = lane & 31, hi = lane >> 5, cmap = wid >> 2, wq = wid & 3;
  const int qwave = qb * 128 + wq * QBLK, qpos = qwave + r32;
  bf16* V_lds = (bf16*)lds; bf16* K_lds = (bf16*)(lds + 2 * SHM_V);
  float* wsf = (float*)(lds + 2 * SHM_V + 2 * SHM_K) + wid * 64; float* li_l = wsf; float* al_l = wsf + 32;
  float m_reg = -1e30f, l_reg = 0; f32x16 o[4] = {}; bf16x8 qr[4];
  const bf16* Qw = proj + (size_t)qpos * DIN + OFF_Q + h * 128 + cmap * 64 + hi * 8;
#pragma unroll
  for (int d0 = 0; d0 < 4; ++d0) qr[d0] = *reinterpret_cast<const bf16x8*>(Qw + d0 * 16);
  const bf16* Kh = proj + OFF_K + h * 128; const bf16* Vh = proj + OFF_V + h * 128;
  float* btl = (float*)(lds + 69632);
  btl[tid] = bt8[tid];
  const float bL = bt8[0], bR = bt8[511];
  const int cbase = cmap * 64;
  const int sr = tid >> 4, sc = (tid & 15) * 8, vst0 = v_st(sr, sc), vst1 = v_st(32 + sr, sc);
  const int vb0 = (int)(uintptr_t)V_lds + v_rd_base(lane);
  struct { bf16x8 vs0, vs1, ks0, ks1; } sr_[SDEPTH];
#define LD8(p) (*reinterpret_cast<const bf16x8*>(p))
#define SLOAD(i, k0) do { sr_[i].vs0 = LD8(&Vh[(size_t)((k0) + sr) * DIN + sc]); sr_[i].vs1 = LD8(&Vh[(size_t)((k0) + 32 + sr) * DIN + sc]); \
    sr_[i].ks0 = LD8(&Kh[(size_t)((k0) + sr) * DIN + sc]); sr_[i].ks1 = LD8(&Kh[(size_t)((k0) + 32 + sr) * DIN + sc]); } while (0)
#define SWRITE(b, i) do { *(bf16x8*)((char*)V_lds + (b) * SHM_V + vst0) = sr_[i].vs0;          \
    *(bf16x8*)((char*)V_lds + (b) * SHM_V + vst1) = sr_[i].vs1; int kc = sc * 2;               \
    *(bf16x8*)((char*)K_lds + (b) * SHM_K + KSWZ(sr, kc)) = sr_[i].ks0;                       \
    *(bf16x8*)((char*)K_lds + (b) * SHM_K + KSWZ(32 + sr, kc)) = sr_[i].ks1; } while (0)
#define SWAIT() do { if constexpr (SDEPTH == 2) asm volatile("s_waitcnt vmcnt(4)" ::: "memory"); else asm volatile("s_waitcnt vmcnt(0)" ::: "memory"); } while (0)
#define RESC(a) do { if (__any((a) < 1.f)) { if (hi == 0) al_l[r32] = (a); asm volatile("s_waitcnt lgkmcnt(0)" ::: "memory"); \
    for (int d = 0; d < 4; ++d) for (int r = 0; r < 16; ++r) o[d][r] *= al_l[crow(r, hi)]; } } while (0)
#define BINIT(P0, P1, t) bias_init(P0, P1, (t) * KVBLK, qwave, qpos, btl, bL, bR, hi)
  f32x16 pA0, pA1, pB0, pB1; float mnA, mnB, alA, alB; bf16x8 pa0, pa1, pa2, pa3; constexpr int NT = S_ / KVBLK;
  constexpr int SE = 0, SO = SDEPTH - 1;
  SLOAD(SE, 0); asm volatile("s_waitcnt vmcnt(0)" ::: "memory"); SWRITE(0, SE); __syncthreads();
  BINIT(pA0, pA1, 0); qkt(pA0, pA1, K_lds, qr, r32, hi, cbase); partialSM(pA0, pA1, m_reg, mnA, alA);
  SLOAD(SO, KVBLK); if constexpr (SDEPTH == 2) SLOAD(SE, 2 * KVBLK);
  SWAIT(); SWRITE(1, SO); __syncthreads();
  for (int j = 1; j + 1 < NT; j += 2) {
    BINIT(pB0, pB1, j);
    SBAR(); qkt(pB0, pB1, (bf16*)((char*)K_lds + SHM_K), qr, r32, hi, cbase);
    finishSM(pA0, pA1, alA, l_reg, pa0, pa1, pa2, pa3); SBAR();
    SLOAD(SO, (j + SDEPTH) * KVBLK); SBAR();
    pv_d0(o, vb0, pa0, pa1, pa2, pa3); partialSM(pB0, pB1, m_reg, mnB, alB);
    __syncthreads(); SWAIT(); SWRITE(0, SE);
    RESC(alB); __syncthreads();
    BINIT(pA0, pA1, j + 1);
    SBAR(); qkt(pA0, pA1, K_lds, qr, r32, hi, cbase);
    finishSM(pB0, pB1, alB, l_reg, pa0, pa1, pa2, pa3); SBAR();
    if (SDEPTH == 1 || j + 3 < NT) SLOAD(SE, (j + 1 + SDEPTH) * KVBLK); SBAR();
    pv_d0(o, vb0 + (int)SHM_V, pa0, pa1, pa2, pa3); partialSM(pA0, pA1, m_reg, mnA, alA);
    __syncthreads(); SWAIT(); SWRITE(1, SO);
    RESC(alA); __syncthreads();
  }
  BINIT(pB0, pB1, NT - 1);
  SBAR(); qkt(pB0, pB1, (bf16*)((char*)K_lds + SHM_K), qr, r32, hi, cbase);
  finishSM(pA0, pA1, alA, l_reg, pa0, pa1, pa2, pa3); SBAR();
  pv_d0(o, vb0, pa0, pa1, pa2, pa3); partialSM(pB0, pB1, m_reg, mnB, alB);
  __syncthreads(); RESC(alB);
  finishSM(pB0, pB1, alB, l_reg, pa0, pa1, pa2, pa3); SBAR();
  pv_d0(o, vb0 + (int)SHM_V, pa0, pa1, pa2, pa3);
  if (hi == 0) li_l[r32] = l_reg; asm volatile("s_waitcnt lgkmcnt(0)" ::: "memory");
  { const float f = cmap ? lam : 1.f;
#pragma unroll
    for (int r = 0; r < 16; ++r) { const float rl = __builtin_amdgcn_rcpf(li_l[crow(r, hi)]) * f;
#pragma unroll
      for (int d0 = 0; d0 < 4; ++d0) o[d0][r] *= rl; } }
  __syncthreads();
  float* X = (float*)lds + wq * 4224;
  if (cmap == 1) {
#pragma unroll
    for (int d0 = 0; d0 < 4; ++d0)
#pragma unroll
      for (int r = 0; r < 16; ++r) X[(d0 * 16 + r) * 64 + lane] = o[d0][r];
  }
  __syncthreads();
  if (cmap == 0) {
    float ss[16];
#pragma unroll
    for (int r = 0; r < 16; ++r) { float s = 0.f;
#pragma unroll
      for (int d0 = 0; d0 < 4; ++d0) { const float v = o[d0][r] - X[(d0 * 16 + r) * 64 + lane]; o[d0][r] = v; s += v * v; }
      ss[r] = s; }
#pragma unroll
    for (int r = 0; r < 16; ++r) { float s = ss[r]; s += __shfl_xor(s, 1); s += __shfl_xor(s, 2); s += __shfl_xor(s, 4); s += __shfl_xor(s, 8); s += __shfl_xor(s, 16);
      ss[r] = rsqrtf(s * (1.f / 128.f) + EPS) * oscale; }
    asm volatile("s_waitcnt lgkmcnt(0)" ::: "memory");
#pragma unroll
    for (int r = 0; r < 16; ++r)
#pragma unroll
      for (int d0 = 0; d0 < 4; ++d0) X[crow(r, hi) * 132 + d0 * 32 + r32] = o[d0][r] * ss[r];
    asm volatile("s_waitcnt lgkmcnt(0)" ::: "memory");
    const int ch = lane & 15;
    const f32x4v g0 = *(const f32x4v*)(ogain + ch * 8), g1 = *(const f32x4v*)(ogain + ch * 8 + 4);
#pragma unroll
    for (int it = 0; it < 8; ++it) { const int row = it * 4 + (lane >> 4);
      const f32x4v a = *(const f32x4v*)(X + row * 132 + ch * 8), b = *(const f32x4v*)(X + row * 132 + ch * 8 + 4);
      const size_t grow = (size_t)(qwave + row);
      const u32x4 bg = *(const u32x4*)(proj + grow * DIN + OFF_BG + h * 128 + ch * 8);
      float y[8] = {a[0] * g0[0], a[1] * g0[1], a[2] * g0[2], a[3] * g0[3], b[0] * g1[0], b[1] * g1[1], b[2] * g1[2], b[3] * g1[3]};
      const unsigned bgw[4] = {bg.x, bg.y, bg.z, bg.w};
#pragma unroll
      for (int e = 0; e < 4; ++e) { y[2 * e] *= silu(__builtin_bit_cast(float, bgw[e] << 16)); y[2 * e + 1] *= silu(__builtin_bit_cast(float, bgw[e] & 0xffff0000u)); }
      u32x4 w = {cvtpk(y[0], y[1]), cvtpk(y[2], y[3]), cvtpk(y[4], y[5]), cvtpk(y[6], y[7])};
      *(u32x4*)(Y + grow * DM + 512 + h * 128 + ch * 8) = w; }
  }
  __syncthreads();
#undef LD8
#undef SLOAD
#undef SWRITE
#undef SWAIT
#undef RESC
#undef BINIT
}
#undef KSWZ
#undef SBAR
}
namespace smm {
using dattn::bf16x8; using dattn::f32x16; using dattn::u32x4; using dattn::f32x4v;
constexpr int TILE = 2 * (int)dattn::SHM_V;
#define SMM_LD8(p) (*reinterpret_cast<const smm::bf16x8*>(p))
__device__ __forceinline__ void mm128(f32x16* o, const bf16* Arow  , int vb) {
#pragma unroll
  for (int t = 0; t < 2; ++t) { const bf16x8 pa0 = SMM_LD8(Arow + t * 64), pa1 = SMM_LD8(Arow + t * 64 + 16), pa2 = SMM_LD8(Arow + t * 64 + 32), pa3 = SMM_LD8(Arow + t * 64 + 48);
    dattn::pv_d0(o, vb + t * (int)dattn::SHM_V, pa0, pa1, pa2, pa3); }
}
__device__ __forceinline__ void f1_item(int n2, int cb, const bf16* __restrict__ proj, const bf16* __restrict__ Fm, const float2* __restrict__ trig, bf16* __restrict__ Tp, char* lds) {
  const int tid = fresh_tid(), wid = tid >> 6, lane = tid & 63, r32 = lane & 31, hi = lane >> 5;
  const int sr = tid >> 4, sc = (tid & 15) * 8;
  { bf16x8 v[4];
#pragma unroll
    for (int p = 0; p < 4; ++p) v[p] = SMM_LD8(proj + (size_t)(64 * (p * 32 + sr) + n2) * DIN + OFF_AIN + cb * 128 + sc);
#pragma unroll
    for (int p = 0; p < 4; ++p) *(bf16x8*)(lds + (p >> 1) * dattn::SHM_V + dattn::v_st((p & 1) * 32 + sr, sc)) = v[p]; }
  __syncthreads();
  f32x16 o[4] = {};
  mm128(o, Fm + (size_t)(wid * 32 + r32) * 128 + hi * 8, (int)(uintptr_t)lds + dattn::v_rd_base(lane));
#pragma unroll
  for (int rr = 0; rr < 8; ++rr) { const int r = (rr & 3) + 8 * (rr >> 2); const int k1 = 16 * wid + (r & 3) + 4 * hi + 8 * (r >> 3);
    const float2 tw = trig[k1 * n2]; bf16* dst = Tp + ((size_t)(k1 * 64 + n2) * 2) * 512 + cb * 128 + r32;
#pragma unroll
    for (int d0 = 0; d0 < 4; ++d0) { const float tr = o[d0][r], ti = o[d0][r + 4];
      dst[d0 * 32] = (bf16)f2bf(tr * tw.x + ti * tw.y); dst[512 + d0 * 32] = (bf16)f2bf(ti * tw.x - tr * tw.y); } }
  __syncthreads();
}
__device__ __forceinline__ void f2_item(int kp, int cb, const bf16* __restrict__ Tp, const bf16* __restrict__ Gm, bf16* __restrict__ X2, char* lds) {
  const int tid = fresh_tid(), wid = tid >> 6, lane = tid & 63, r32 = lane & 31, hi = lane >> 5, wq = wid & 3;
  const int sr = tid >> 4, sc = (tid & 15) * 8;
#pragma unroll
  for (int t2 = 0; t2 < 2; ++t2) { bf16x8 v[4]; const bf16* src = Tp + (size_t)(2 * kp + t2) * 128 * 512 + cb * 128 + sc;
#pragma unroll
    for (int p = 0; p < 4; ++p) v[p] = SMM_LD8(src + (size_t)(p * 32 + sr) * 512);
#pragma unroll
    for (int p = 0; p < 4; ++p) *(bf16x8*)(lds + t2 * TILE + (p >> 1) * dattn::SHM_V + dattn::v_st((p & 1) * 32 + sr, sc)) = v[p]; }
  __syncthreads();
  f32x16 o[4] = {};
  mm128(o, Gm + (size_t)(wq * 32 + r32) * 128 + hi * 8, (int)(uintptr_t)lds + (wid >> 2) * TILE + dattn::v_rd_base(lane));
  const int k1 = 2 * kp + (wid >> 2);
#pragma unroll
  for (int r = 0; r < 16; ++r) { const int k2 = 16 * wq + (r & 3) + 4 * hi + 8 * (r >> 3), part = (r >> 2) & 1;
    bf16* dst = X2 + (size_t)(k1 * 64 + k2) * 1024 + part * 512 + cb * 128 + r32;
#pragma unroll
    for (int d0 = 0; d0 < 4; ++d0) dst[d0 * 32] = (bf16)f2bf(o[d0][r]); }
  __syncthreads();
}
__device__ __forceinline__ void sgu_item(int chk, int gp, const bf16* __restrict__ proj, const float* __restrict__ vgain, const float* __restrict__ wsp, const float* __restrict__ bsp, bf16* __restrict__ Y, char* lds) {
  const int tid = fresh_tid(), wid = tid >> 6, lane = tid & 63, r32 = lane & 31, hi = lane >> 5, wq = wid & 3;
  const int sr = tid >> 4, sc = (tid & 15) * 8;
#pragma unroll
  for (int t2 = 0; t2 < 2; ++t2) { const int g = 2 * gp + t2; u32x4 v[4]; const bf16* src = proj + (size_t)(chk * 128) * DIN + OFF_VS + g * 128 + sc;
#pragma unroll
    for (int p = 0; p < 4; ++p) v[p] = *(const u32x4*)(src + (size_t)(p * 32 + sr) * DIN);
    const f32x4v g0 = *(const f32x4v*)(vgain + g * 128 + sc), g1 = *(const f32x4v*)(vgain + g * 128 + sc + 4);
#pragma unroll
    for (int p = 0; p < 4; ++p) { const unsigned w[4] = {v[p].x, v[p].y, v[p].z, v[p].w}; float f[8]; float ss = 0.f;
#pragma unroll
      for (int e = 0; e < 4; ++e) { f[2 * e] = __builtin_bit_cast(float, w[e] << 16); f[2 * e + 1] = __builtin_bit_cast(float, w[e] & 0xffff0000u); ss += f[2 * e] * f[2 * e] + f[2 * e + 1] * f[2 * e + 1]; }
      ss += __shfl_xor(ss, 1); ss += __shfl_xor(ss, 2); ss += __shfl_xor(ss, 4); ss += __shfl_xor(ss, 8);
      const float rs = rsqrtf(ss * (1.f / 128.f) + EPS);
      u32x4 q = {dattn::cvtpk(f[0] * rs * g0[0], f[1] * rs * g0[1]), dattn::cvtpk(f[2] * rs * g0[2], f[3] * rs * g0[3]), dattn::cvtpk(f[4] * rs * g1[0], f[5] * rs * g1[1]), dattn::cvtpk(f[6] * rs * g1[2], f[7] * rs * g1[3])};
      *(u32x4*)(lds + t2 * TILE + (p >> 1) * dattn::SHM_V + dattn::v_st((p & 1) * 32 + sr, sc)) = q; } }
  __syncthreads();
  const int g = 2 * gp + (wid >> 2);
  f32x16 o[4] = {};
  { const float* Arow = wsp + (size_t)(g * 128 + wq * 32 + r32) * 128 + hi * 8; const int vb = (int)(uintptr_t)lds + (wid >> 2) * TILE + dattn::v_rd_base(lane);
#pragma unroll
    for (int t = 0; t < 2; ++t) { bf16x8 pa[4];
#pragma unroll
      for (int k = 0; k < 4; ++k) { const f32x4v a = *(const f32x4v*)(Arow + t * 64 + k * 16), b = *(const f32x4v*)(Arow + t * 64 + k * 16 + 4);
        u32x4 w = {dattn::cvtpk(a[0], a[1]), dattn::cvtpk(a[2], a[3]), dattn::cvtpk(b[0], b[1]), dattn::cvtpk(b[2], b[3])}; pa[k] = *reinterpret_cast<bf16x8*>(&w); }
      dattn::pv_d0(o, vb + t * (int)dattn::SHM_V, pa[0], pa[1], pa[2], pa[3]); } }
  __syncthreads();
  float* X = (float*)lds + wid * 4224;
#pragma unroll
  for (int r = 0; r < 16; ++r) { const float bb = bsp[g * 128 + wq * 32 + dattn::crow(r, hi)];
#pragma unroll
    for (int d0 = 0; d0 < 4; ++d0) X[dattn::crow(r, hi) * 132 + d0 * 32 + r32] = o[d0][r] + bb; }
  asm volatile("s_waitcnt lgkmcnt(0)" ::: "memory");
  const int c16 = lane & 15;
#pragma unroll
  for (int it = 0; it < 8; ++it) { const int row = it * 4 + (lane >> 4);
    const f32x4v a = *(const f32x4v*)(X + row * 132 + c16 * 8), b = *(const f32x4v*)(X + row * 132 + c16 * 8 + 4);
    const size_t pos = (size_t)(chk * 128 + wq * 32 + row);
    const u32x4 uu = *(const u32x4*)(proj + pos * DIN + OFF_U + g * 128 + c16 * 8), cgv = *(const u32x4*)(proj + pos * DIN + OFF_CG + g * 128 + c16 * 8);
    float y[8] = {a[0], a[1], a[2], a[3], b[0], b[1], b[2], b[3]};
    const unsigned uw[4] = {uu.x, uu.y, uu.z, uu.w}, cw[4] = {cgv.x, cgv.y, cgv.z, cgv.w};
#pragma unroll
    for (int e = 0; e < 4; ++e) { y[2 * e] *= __builtin_bit_cast(float, uw[e] << 16) * silu(__builtin_bit_cast(float, cw[e] << 16));
      y[2 * e + 1] *= __builtin_bit_cast(float, uw[e] & 0xffff0000u) * silu(__builtin_bit_cast(float, cw[e] & 0xffff0000u)); }
    u32x4 w = {dattn::cvtpk(y[0], y[1]), dattn::cvtpk(y[2], y[3]), dattn::cvtpk(y[4], y[5]), dattn::cvtpk(y[6], y[7])};
    *(u32x4*)(Y + pos * DM + 1536 + g * 128 + c16 * 8) = w; }
  __syncthreads();
}
}
struct EpiYa {
    static constexpr bool PERM = true, AFTER_DRAIN = false;
    bf16* Y; const bf16* proj;
    __device__ __forceinline__ void operator()(const pg8::f32x4 (&acc)[2][2][4][2], const pg8::Unit& u, int wr, int wc, int fr, int fq) const {
        const int rho0 = u.pm * pg8::BM + wr * 64 + fr; const int col0 = u.pn * pg8::BM + wc * 32 + 8 * fq;
#pragma unroll
        for (int ai = 0; ai < 2; ++ai)
#pragma unroll
            for (int m = 0; m < 4; ++m) { const int rho = rho0 + ai * pg8::HALF + m * 16; const size_t row = (size_t)((rho >> 6) + 128 * (rho & 63));
#pragma unroll
                for (int bj = 0; bj < 2; ++bj) { const int col = col0 + bj * pg8::HALF; const pg8::f32x4 v0 = acc[ai][bj][m][0], v1 = acc[ai][bj][m][1];
                    const pg8::u32x4 gt = *(const pg8::u32x4*)(proj + row * DIN + OFF_AG + col);
                    const unsigned gw[4] = {gt.x, gt.y, gt.z, gt.w}; float y[8] = {v0[0], v0[1], v0[2], v0[3], v1[0], v1[1], v1[2], v1[3]};
#pragma unroll
                    for (int e = 0; e < 4; ++e) { y[2 * e] *= silu(__builtin_bit_cast(float, gw[e] << 16)); y[2 * e + 1] *= silu(__builtin_bit_cast(float, gw[e] & 0xffff0000u)); }
                    pg8::u32x4 w; w.x = pg8::cvt_pk_bf16(y[0], y[1]); w.y = pg8::cvt_pk_bf16(y[2], y[3]); w.z = pg8::cvt_pk_bf16(y[4], y[5]); w.w = pg8::cvt_pk_bf16(y[6], y[7]);
                    *(pg8::u32x4*)(Y + row * DM + col) = w; } }
    }
};
#include <hip/hip_cooperative_groups.h>
namespace cg = cooperative_groups;
struct Args { const float* in[12]; float* out; unsigned char* ws; };
#define GRID_SYNC() grid.sync()
typedef const __attribute__((address_space(4))) unsigned char* kargp_t;
#define KARG(i) (*(const volatile __attribute__((address_space(4))) unsigned long long*)(kargs + 8 * (i)))
#define A_IN(i) ((const float*)(const GAS float*)KARG(i))
#define A_X A_IN(0)
#define A_WIN A_IN(1)
#define A_PREG A_IN(2)
#define A_POSTG A_IN(3)
#define A_WF A_IN(4)
#define A_LQK A_IN(5)
#define A_OGAIN A_IN(6)
#define A_VGAIN A_IN(7)
#define A_WS A_IN(8)
#define A_BS A_IN(9)
#define A_WOUT A_IN(10)
#define A_RELB A_IN(11)
#define A_OUT ((float*)(GAS float*)KARG(12))
#define A_WSP ((unsigned char*)(GAS unsigned char*)KARG(13))
#define W_TRIG ((float2*)(A_WSP + WS_TAB))
#define W_BIAS ((float*)(A_WSP + WS_BIAS))
#define W_BIAS8 ((float*)(A_WSP + WS_BIAS + 16384))
#define W_LAM ((float*)(A_WSP + WS_LAM))
#define W_RSTDSG ((float*)(A_WSP + WS_RSTDSG))
#define W_FM ((bf16*)(A_WSP + WS_FM))
#define W_GM ((bf16*)(A_WSP + WS_GM))
#define W_WINT ((bf16*)(A_WSP + WS_WINT))
#define W_WOUTT ((bf16*)(A_WSP + WS_WOUTT))
#define W_WF2T ((bf16*)(A_WSP + WS_WF2T))
#define W_XN ((bf16*)(A_WSP + WS_XN))
#define W_PROJ ((bf16*)(A_WSP + WS_PROJ))
#define W_TP ((bf16*)(A_WSP + WS_TP))
#define W_X2 ((bf16*)(A_WSP + WS_X2))
#define W_Y ((bf16*)(A_WSP + WS_Y))
#define W_YOUT ((float*)(A_WSP + WS_YOUT))
__global__ void __launch_bounds__(NTHR, 2) mega_fwd(Args a) {
    extern __shared__ __attribute__((aligned(16))) unsigned char lds[];
    cg::grid_group grid = cg::this_grid();
    const kargp_t kargs = (kargp_t)__builtin_amdgcn_kernarg_segment_ptr();
    LAS unsigned char* L = (LAS unsigned char*)lds;

    {
        const int ftid = fresh_tid(); const int lane = ftid & 63, wave = __builtin_amdgcn_readfirstlane(ftid >> 6);
        const int gw = (int)blockIdx.x * NWAVES + wave, NGW = (int)gridDim.x * NWAVES;
        LAS float* scr = (LAS float*)(L + wave * 16384);
        constexpr int I_IN = (DM / 64) * (DIN / 32), I_OUT = (DM / 64) * (DM / 32), I_L = I_IN + I_OUT;
        { const float* w_in = A_WIN; const float* w_out = A_WOUT; bf16* WinT = W_WINT; bf16* WoutT = W_WOUTT;
          for (int it = gw; it < DEPTH * I_L; it += NGW) { const int l = it / I_L, r = it % I_L;
            if (r < I_IN) p0_transpose_item(w_in + (size_t)l * DM * DIN, DM, DIN, WinT + (size_t)l * DIN * DM, scr, r, lane);
            else p0_transpose_item(w_out + (size_t)l * DM * DM, DM, DM, WoutT + (size_t)l * DM * DM, scr, r - I_IN, lane); } }
        ph_wf2(A_WF, W_WF2T); ph_wf2(A_WF + (size_t)DF * DF, W_WF2T + (size_t)512 * 1024);
        ph_tables(A_RELB, A_LQK, W_TRIG, W_BIAS, W_BIAS8, W_LAM, W_FM, W_GM);
        { const float* xp = A_X; const float* pg = A_PREG; bf16* XN = W_XN;
          for (int row = gw; row < S_; row += NGW) { const float4* xr = (const float4*)(xp + (size_t)row * DM) + lane; float4 v[8];
#pragma unroll
            for (int j = 0; j < 8; ++j) v[j] = xr[64 * j];
            rms_row_to_bf16(v, pg, XN + (size_t)row * DM, lane); } }
    }
    GRID_SYNC();
#pragma unroll
    for (int l = 0; l < DEPTH; ++l) {
        { pg8::Gemm g{W_XN, W_WINT + (size_t)l * DIN * DM, S_, DIN, DM}; pg8::StaticOrder S; S.init(S_, DIN, (int)gridDim.x, (int)blockIdx.x);
          pg8::EpiBf16 E{W_PROJ, DIN};
          pg8::gemm_phase<pg8::EpiBf16, pg8::StaticOrder, true, true>(L, g, S, E); }
        GRID_SYNC();
#ifdef X_NAIVE_SMALL
        ph_f1_naive(W_PROJ, W_TRIG, W_TP); ph_sgu_rstd(W_PROJ, W_RSTDSG);
        GRID_SYNC();
        ph_f2_naive(W_TP, W_TRIG, W_X2);
        ph_sgu_naive(W_PROJ, W_RSTDSG, A_VGAIN + l * DG, A_WS + (size_t)l * 4 * 128 * 128, A_BS + l * 4 * 128, W_Y);
        GRID_SYNC();
        ph_ya_naive(W_X2, W_WF2T + (size_t)l * 512 * 1024, W_PROJ, W_Y);
#else
        { const bf16* proj = W_PROJ; const bf16* Fm = W_FM; const float2* trig = W_TRIG; bf16* Tp = W_TP; bf16* Yp = W_Y;
          const float* vg = A_VGAIN + l * DG; const float* wsp = A_WS + (size_t)l * 4 * 128 * 128; const float* bsp = A_BS + l * 4 * 128;
          for (int it = (int)blockIdx.x; it < 384; it += (int)gridDim.x) {
            if (it < 256) smm::f1_item(it & 63, it >> 6, proj, Fm, trig, Tp, (char*)lds);
            else smm::sgu_item((it - 256) >> 1, (it - 256) & 1, proj, vg, wsp, bsp, Yp, (char*)lds); } }
        GRID_SYNC();
        { const bf16* Tp = W_TP; const bf16* Gm = W_GM; bf16* X2 = W_X2;
          for (int it = (int)blockIdx.x; it < 256; it += (int)gridDim.x) smm::f2_item(it & 63, it >> 6, Tp, Gm, X2, (char*)lds); }
        GRID_SYNC();
        { pg8::Gemm g{W_X2, W_WF2T + (size_t)l * 512 * 1024, S_, 512, 1024}; pg8::StaticOrder S; S.init(S_, 512, (int)gridDim.x, (int)blockIdx.x);
          EpiYa E{W_Y, W_PROJ};
          pg8::gemm_phase<EpiYa, pg8::StaticOrder, true, true>(L, g, S, E); }
#endif
        { const bf16* proj = W_PROJ; const float* bt8 = W_BIAS8; const float lamv = W_LAM[l]; const float* og = A_OGAIN + l * DD; bf16* Yp = W_Y;
          for (int u = (int)blockIdx.x; u < NH * (S_ / 128); u += (int)gridDim.x) { const int hh = u & 7, qb = u >> 3;
            dattn::dattn_unit(hh, qb, proj, bt8 + hh * 512, lamv, 1.f - lambda_init(l), og + hh * 128, Yp, (char*)lds); } }
        GRID_SYNC();
        { pg8::Gemm g{W_Y, W_WOUTT + (size_t)l * DM * DM, S_, DM, DM}; pg8::StaticOrder S; S.init(S_, DM, (int)gridDim.x, (int)blockIdx.x);
          pg8::EpiF32 E{W_YOUT, DM};
          pg8::gemm_phase<pg8::EpiF32, pg8::StaticOrder, true, true>(L, g, S, E); }
        GRID_SYNC();
        { const int ftid = fresh_tid(); const int lane = ftid & 63, wave = __builtin_amdgcn_readfirstlane(ftid >> 6);
          const int gw = (int)blockIdx.x * NWAVES + wave, NGW = (int)gridDim.x * NWAVES;
          const float* yo = W_YOUT; const float* pg = A_POSTG + l * DM; const float* xs = (l == 0 ? A_X : (const float*)A_OUT); float* outp = A_OUT; bf16* XN = W_XN; const float* pre = A_PREG + (l + 1 < DEPTH ? (l + 1) * DM : 0);
          for (int row = gw; row < S_; row += NGW) {
            const float4* yr = (const float4*)(yo + (size_t)row * DM) + lane; const float4* gr = (const float4*)pg + lane; const float4* xr = (const float4*)(xs + (size_t)row * DM) + lane;
            float4 v[8]; float ss = 0.f;
#pragma unroll
            for (int j = 0; j < 8; ++j) { v[j] = yr[64 * j]; ss += v[j].x * v[j].x + v[j].y * v[j].y + v[j].z * v[j].z + v[j].w * v[j].w; }
            const float rstd = rsqrtf(wave_sum(ss) * (1.f / DM) + EPS);
            float4* o = (float4*)(outp + (size_t)row * DM) + lane;
#pragma unroll
            for (int j = 0; j < 8; ++j) { const float4 g = gr[64 * j]; const float4 xv = xr[64 * j];
                v[j] = make_float4(xv.x + v[j].x * rstd * g.x, xv.y + v[j].y * rstd * g.y, xv.z + v[j].z * rstd * g.z, xv.w + v[j].w * rstd * g.w); o[64 * j] = v[j]; }
            if (l + 1 < DEPTH) rms_row_to_bf16(v, pre, XN + (size_t)row * DM, lane);
          } }
        if (l + 1 < DEPTH) GRID_SYNC();
    }
}

extern "C" void kernel_launch(void* const* d_in, const int* in_sizes, int n_in, void* d_out, int out_size, void* d_ws, size_t ws_size, hipStream_t stream) {
    static int grid = 0;
    if (grid == 0) {
        if (n_in != 12 || ws_size < WS_END) { fprintf(stderr, "kernel_launch: unexpected n_in %d / ws %zu\n", n_in, ws_size); grid = -1; return; }
        int dev = 0, cus = 0, per_cu = 0;
        if (hipGetDevice(&dev) != hipSuccess || hipDeviceGetAttribute(&cus, hipDeviceAttributeMultiprocessorCount, dev) != hipSuccess) { grid = -1; return; }
        if (hipFuncSetAttribute((const void*)mega_fwd, hipFuncAttributeMaxDynamicSharedMemorySize, LDS_BYTES) != hipSuccess) { fprintf(stderr, "kernel_launch: hipFuncSetAttribute failed\n"); grid = -1; return; }
        if (hipOccupancyMaxActiveBlocksPerMultiprocessor(&per_cu, (const void*)mega_fwd, NTHR, LDS_BYTES) != hipSuccess || per_cu < 1) { fprintf(stderr, "kernel_launch: occupancy query failed (%d)\n", per_cu); (void)hipGetLastError(); grid = -1; return; }
        grid = cus * per_cu;
    }
    if (grid < 0) return;
    Args a{};
    for (int i = 0; i < 12; ++i) a.in[i] = (const float*)d_in[i];
    a.out = (float*)d_out; a.ws = (unsigned char*)d_ws;
    void* args[] = {&a};
    hipError_t e = hipLaunchCooperativeKernel((const void*)mega_fwd, dim3(grid), dim3(NTHR), args, LDS_BYTES, stream);
    if (e != hipSuccess) fprintf(stderr, "cooperative launch failed: %s (grid %d)\n", hipGetErrorString(e), grid);
}
```

```cpp
#include <hip/hip_runtime.h>
#include <cstdio>
#include <cstdint>
__device__ __forceinline__ int fresh_tid() { int t = (int)threadIdx.x; asm volatile("" : "+v"(t)); return t; }
namespace pg8 {
#define PG8_LAS __attribute__((address_space(3)))
typedef unsigned short bf16_t;
typedef short bf16x8 __attribute__((ext_vector_type(8)));
typedef float f32x4 __attribute__((ext_vector_type(4)));
typedef unsigned u32x4 __attribute__((ext_vector_type(4)));
constexpr int BM = 256, BK = 64, HALF = 128, HTB = HALF * BK * 2  , STAGE_BYTES = 8 * HTB, NXCD = 8, WGM = 8;

__host__ __device__ __forceinline__ int lds_byte(int r, int c) { const int st = (r >> 4) * 2 + (c >> 5), rr = r & 15, cc = c & 31, ob = rr * 64 + cc * 2; return st * 1024 + (ob ^ (((ob >> 9) & 1) << 5)); }
__host__ __device__ __forceinline__ void stage_rc(int b, int& R, int& C) { const int st = b / 1024, sb = b % 1024, swz = sb ^ (((sb >> 9) & 1) << 5); R = (st >> 1) * 16 + swz / 64; C = (st & 1) * 32 + (swz % 64) / 2; }
__host__ __device__ __forceinline__ int perm32(int rho) { const int n = rho >> 4, i = rho & 15; return 8 * (i >> 2) + 4 * n + (i & 3); }

struct Unit { int pm, pn; };
struct Gemm { const bf16_t* A; const bf16_t* Bt; int M, N, K; };

struct StaticOrder {
    int nM, nN, nwg, G, c;
    __host__ __device__ void init(int M, int N, int G_, int c_) { nM = M / BM; nN = N / BM; nwg = nM * nN; G = G_; c = c_; }
    __host__ __device__ bool next(int i, Unit& u) const {
        const long L = (long)i * G + c; if (L >= nwg) return false;
        int wgid = (int)L; { const int q = nwg / NXCD, r = nwg % NXCD, xcd = wgid % NXCD, off = wgid / NXCD; wgid = (xcd < r ? xcd * (q + 1) : r * (q + 1) + (xcd - r) * q) + off; }
        const int nig = WGM * nN, gid = wgid / nig, fm = gid * WGM, gsz = (nM - fm) < WGM ? (nM - fm) : WGM;
        u.pm = fm + ((wgid % nig) % gsz); u.pn = (wgid % nig) / gsz; return true;
    }
    __device__ __forceinline__ void a_ready(const Unit&) const {}
    __device__ __forceinline__ void done(const Unit&) const {}
};

__device__ __forceinline__ unsigned cvt_pk_bf16(float lo, float hi) { unsigned r; asm volatile("v_cvt_pk_bf16_f32 %0, %1, %2" : "=v"(r) : "v"(lo), "v"(hi)); return r; }
struct EpiBf16 {
    static constexpr bool PERM = true, AFTER_DRAIN = false;
    bf16_t* O; int ldc;
    __device__ __forceinline__ void operator()(const f32x4 (&acc)[2][2][4][2], const Unit& u, int wr, int wc, int fr, int fq) const {
        const int row0 = u.pm * BM + wr * 64 + fr; const int col0 = u.pn * BM + wc * 32 + 8 * fq;
#pragma unroll
        for (int ai = 0; ai < 2; ++ai)
#pragma unroll
            for (int m = 0; m < 4; ++m) { bf16_t* rowp = O + (size_t)(row0 + ai * HALF + m * 16) * ldc + col0;
#pragma unroll
                for (int bj = 0; bj < 2; ++bj) { const f32x4 v0 = acc[ai][bj][m][0], v1 = acc[ai][bj][m][1];
                    u32x4 w; w.x = cvt_pk_bf16(v0[0], v0[1]); w.y = cvt_pk_bf16(v0[2], v0[3]); w.z = cvt_pk_bf16(v1[0], v1[1]); w.w = cvt_pk_bf16(v1[2], v1[3]);
                    *(u32x4*)(rowp + bj * HALF) = w; } }
    }
};
struct EpiF32 {
    static constexpr bool PERM = false, AFTER_DRAIN = false;
    float* C; int ldc;
    __device__ __forceinline__ void operator()(const f32x4 (&acc)[2][2][4][2], const Unit& u, int wr, int wc, int fr, int fq) const {
        const int row0 = u.pm * BM + wr * 64 + fr, col0 = u.pn * BM + wc * 32 + 4 * fq;
#pragma unroll
        for (int ai = 0; ai < 2; ++ai)
#pragma unroll
            for (int m = 0; m < 4; ++m) { float* rowp = C + (size_t)(row0 + ai * HALF + m * 16) * ldc + col0;
#pragma unroll
                for (int bj = 0; bj < 2; ++bj)
#pragma unroll
                    for (int n = 0; n < 2; ++n) *(f32x4*)(rowp + bj * HALF + n * 16) = acc[ai][bj][m][n]; }
    }
};
template <class Epi, class Sched, bool ALIGN_EPI = false, bool SP2 = false>
__device__ __forceinline__ void gemm_phase(PG8_LAS unsigned char* lds, const Gemm g, const Sched& S, const Epi& E) {
    const int tid = fresh_tid(), wid = __builtin_amdgcn_readfirstlane(tid >> 6), lane = tid & 63, wr = wid >> 2, wc = wid & 3, fr = lane & 15, fq = lane >> 4;
    const int K = g.K, nt = K / BK;
    unsigned voffA[2], voffB[2];
#pragma unroll
    for (int i = 0; i < 2; ++i) { int R, C; stage_rc(tid * 16 + i * 8192, R, C); const int Rb = Epi::PERM ? ((R & ~31) + perm32(R & 31)) : R;
        voffA[i] = (unsigned)(R * K + C) * 2u; voffB[i] = (unsigned)(Rb * K + C) * 2u; }
    const size_t kstep = (size_t)(BK * 2);
    const size_t hstep = (size_t)HALF * K * 2;
    const size_t tstep = 2 * hstep;
    const unsigned ldsw = (unsigned)wid * 1024u;
    const int aoff = lds_byte(wr * 64 + fr, fq * 8), boff = lds_byte(wc * 32 + fr, fq * 8);
#define PG8_SA(b, h) (((b) * 2 + (h)) * HTB)
#define PG8_SB(b, h) ((4 + (b) * 2 + (h)) * HTB)
#define PG8_STAGE(bufoff, gbase, voff) do { _Pragma("unroll") for (int _i = 0; _i < 2; ++_i) \
        __builtin_amdgcn_global_load_lds((const unsigned*)((const char*)(gbase) + (voff)[_i]), (PG8_LAS unsigned*)(lds + (bufoff) + ldsw + _i * 8192), 16, 0, 0); } while (0)
#define PG8_LDA(dst, b, h) do { _Pragma("unroll") for (int m = 0; m < 4; ++m) _Pragma("unroll") for (int k = 0; k < 2; ++k) dst[m][k] = *(const PG8_LAS bf16x8*)(lds + PG8_SA(b, h) + aoff + m * 2048 + k * 1024); } while (0)
#define PG8_LDB(dst, b, h) do { _Pragma("unroll") for (int n = 0; n < 2; ++n) _Pragma("unroll") for (int k = 0; k < 2; ++k) dst[n][k] = *(const PG8_LAS bf16x8*)(lds + PG8_SB(b, h) + boff + n * 2048 + k * 1024); } while (0)
#define PG8_MMA(ai, bj, At, Bt) do { __builtin_amdgcn_s_setprio(1); _Pragma("unroll") for (int m = 0; m < 4; ++m) _Pragma("unroll") for (int n = 0; n < 2; ++n) _Pragma("unroll") for (int k = 0; k < 2; ++k) \
        acc[ai][bj][m][n] = __builtin_amdgcn_mfma_f32_16x16x32_bf16(Bt[n][k], At[m][k], acc[ai][bj][m][n], 0, 0, 0); __builtin_amdgcn_s_setprio(0); } while (0)
#define PG8_WAIT_V(n) asm volatile("s_waitcnt vmcnt(" #n ")" ::: "memory")
#define PG8_WAIT_L(n) asm volatile("s_waitcnt lgkmcnt(" #n ")" ::: "memory")
#define PG8_BAR __builtin_amdgcn_s_barrier()
#define PG8_SCHED __builtin_amdgcn_sched_barrier(0)
    Unit cur, nxt; int ui = 0;
    if (!S.next(0, cur)) return;
    f32x4 acc[2][2][4][2];
#pragma unroll
    for (int a = 0; a < 2; ++a)
#pragma unroll
        for (int b = 0; b < 2; ++b)
#pragma unroll
            for (int m = 0; m < 4; ++m)
#pragma unroll
                for (int n = 0; n < 2; ++n) acc[a][b][m][n] = (f32x4){0.f, 0.f, 0.f, 0.f};
    bf16x8 At[4][2], B0[2][2], B1[2][2];
    const char* cA = (const char*)g.A + (size_t)cur.pm * tstep; const char* cB = (const char*)g.Bt + (size_t)cur.pn * tstep;
    S.a_ready(cur);
    if constexpr (SP2) {
        PG8_STAGE(PG8_SB(0, 0), cB, voffB); PG8_STAGE(PG8_SB(0, 1), cB + hstep, voffB); PG8_STAGE(PG8_SA(0, 0), cA, voffA); PG8_STAGE(PG8_SA(0, 1), cA + hstep, voffA);
        if (wr == 1) PG8_BAR;
        PG8_WAIT_V(2); PG8_BAR;
        PG8_STAGE(PG8_SB(1, 0), cB + kstep, voffB); PG8_STAGE(PG8_SA(1, 0), cA + kstep, voffA); PG8_STAGE(PG8_SB(1, 1), cB + hstep + kstep, voffB);
        PG8_WAIT_V(6); PG8_BAR;
    } else {
        PG8_STAGE(PG8_SB(0, 0), cB, voffB); PG8_STAGE(PG8_SA(0, 0), cA, voffA); PG8_STAGE(PG8_SB(0, 1), cB + hstep, voffB); PG8_STAGE(PG8_SA(0, 1), cA + hstep, voffA);
        if (wr == 1) PG8_BAR;
        PG8_WAIT_V(4); PG8_BAR;
        PG8_STAGE(PG8_SB(1, 0), cB + kstep, voffB); PG8_STAGE(PG8_SA(1, 0), cA + kstep, voffA); PG8_STAGE(PG8_SB(1, 1), cB + hstep + kstep, voffB);
        PG8_WAIT_V(6); PG8_BAR;
    }
    for (;;) {
        const bool has_next = S.next(ui + 1, nxt);
        const char* nA = has_next ? (const char*)g.A + (size_t)nxt.pm * tstep : cA; const char* nB = has_next ? (const char*)g.Bt + (size_t)nxt.pn * tstep : cB;
        for (int t = 0; t < nt; t += 2) {
            const bool last = (t == nt - 2);
            const char* a1 = cA + (size_t)(t + 1) * kstep;
            const char* a2 = last ? nA : cA + (size_t)(t + 2) * kstep; const char* b2 = last ? nB : cB + (size_t)(t + 2) * kstep;
            const char* a3 = a2 + kstep; const char* b3 = b2 + kstep;
            if (last && has_next) S.a_ready(nxt);
            if constexpr (SP2) {
            PG8_LDB(B0, 0, 0); PG8_LDB(B1, 0, 1); PG8_SCHED; PG8_LDA(At, 0, 0); PG8_STAGE(PG8_SA(1, 1), a1 + hstep, voffA);
            PG8_WAIT_V(8); PG8_WAIT_L(0); PG8_BAR; PG8_MMA(0, 0, At, B0); PG8_MMA(0, 1, At, B1); PG8_BAR; PG8_SCHED;
            PG8_LDA(At, 0, 1); PG8_STAGE(PG8_SB(0, 0), b2, voffB); PG8_STAGE(PG8_SB(0, 1), b2 + hstep, voffB); PG8_STAGE(PG8_SA(0, 0), a2, voffA);
            PG8_WAIT_V(8); PG8_WAIT_L(0); PG8_BAR; PG8_MMA(1, 0, At, B0); PG8_MMA(1, 1, At, B1); PG8_BAR; PG8_SCHED;
            PG8_LDB(B0, 1, 0); PG8_LDB(B1, 1, 1); PG8_SCHED; PG8_LDA(At, 1, 0); PG8_STAGE(PG8_SA(0, 1), a2 + hstep, voffA);
            PG8_WAIT_V(8); PG8_WAIT_L(0); PG8_BAR; PG8_MMA(0, 0, At, B0); PG8_MMA(0, 1, At, B1); PG8_BAR; PG8_SCHED;
            PG8_LDA(At, 1, 1); PG8_STAGE(PG8_SB(1, 0), b3, voffB); PG8_STAGE(PG8_SB(1, 1), b3 + hstep, voffB); PG8_STAGE(PG8_SA(1, 0), a3, voffA);
            PG8_WAIT_V(8); PG8_WAIT_L(0); PG8_BAR; PG8_MMA(1, 0, At, B0); PG8_MMA(1, 1, At, B1); PG8_BAR; PG8_SCHED;
            } else {
            PG8_LDB(B0, 0, 0); PG8_SCHED; PG8_LDA(At, 0, 0); PG8_STAGE(PG8_SA(1, 1), a1 + hstep, voffA);
            PG8_WAIT_L(8); PG8_BAR; PG8_WAIT_L(0); PG8_MMA(0, 0, At, B0); PG8_BAR; PG8_SCHED;
            PG8_LDB(B1, 0, 1); PG8_STAGE(PG8_SB(0, 0), b2, voffB);
            PG8_BAR; PG8_WAIT_L(0); PG8_MMA(0, 1, At, B1); PG8_BAR;
            PG8_LDA(At, 0, 1); PG8_STAGE(PG8_SA(0, 0), a2, voffA);
            PG8_BAR; PG8_WAIT_L(0); PG8_MMA(1, 0, At, B0); PG8_BAR; PG8_SCHED;
            PG8_STAGE(PG8_SB(0, 1), b2 + hstep, voffB);
            PG8_WAIT_V(6); PG8_BAR; PG8_MMA(1, 1, At, B1); PG8_BAR;
            PG8_LDB(B0, 1, 0); PG8_SCHED; PG8_LDA(At, 1, 0); PG8_STAGE(PG8_SA(0, 1), a2 + hstep, voffA);
            PG8_WAIT_L(8); PG8_BAR; PG8_WAIT_L(0); PG8_MMA(0, 0, At, B0); PG8_BAR; PG8_SCHED;
            PG8_LDB(B1, 1, 1); PG8_STAGE(PG8_SB(1, 0), b3, voffB);
            PG8_BAR; PG8_WAIT_L(0); PG8_MMA(0, 1, At, B1); PG8_BAR;
            PG8_LDA(At, 1, 1); PG8_STAGE(PG8_SA(1, 0), a3, voffA);
            PG8_BAR; PG8_WAIT_L(0); PG8_MMA(1, 0, At, B0); PG8_BAR; PG8_SCHED;
            PG8_STAGE(PG8_SB(1, 1), b3 + hstep, voffB);
            PG8_WAIT_V(6); PG8_BAR; PG8_MMA(1, 1, At, B1); PG8_BAR;
            }
        }
        if constexpr (ALIGN_EPI) { if (wr == 0) PG8_BAR; }
        if constexpr (!Epi::AFTER_DRAIN) { E(acc, cur, wr, wc, fr, fq); S.done(cur); }
        if (!has_next) break;
#pragma unroll
        for (int a = 0; a < 2; ++a)
#pragma unroll
            for (int b = 0; b < 2; ++b)
#pragma unroll
                for (int m = 0; m < 4; ++m)
#pragma unroll
                    for (int n = 0; n < 2; ++n) acc[a][b][m][n] = (f32x4){0.f, 0.f, 0.f, 0.f};
        cur = nxt; cA = nA; cB = nB; ++ui;
        if constexpr (ALIGN_EPI) { if (wr == 1) PG8_BAR; }
    }
    PG8_WAIT_V(0);
    if constexpr (!ALIGN_EPI) { if (wr == 0) PG8_BAR; }
    PG8_BAR;
    if constexpr (Epi::AFTER_DRAIN) { E.fused(acc, cur, wr, wc, fr, fq, lds, wid, lane); S.done(cur); }
#undef PG8_SA
#undef PG8_SB
#undef PG8_STAGE
#undef PG8_LDA
#undef PG8_LDB
#undef PG8_MMA
#undef PG8_WAIT_V
#undef PG8_WAIT_L
#undef PG8_BAR
#undef PG8_SCHED
}
}
typedef unsigned short bf16;
constexpr int S_ = 8192, DM = 2048, DIN = 6656, DF = 512, DD = 1024, DG = 512, NH = 8, DEPTH = 2;
constexpr int OFF_AIN = 0, OFF_AG = 512, OFF_Q = 1024, OFF_K = 2048, OFF_V = 3072, OFF_BG = 4096, OFF_U = 5120, OFF_VS = 5632, OFF_CG = 6144;
constexpr float EPS = 1e-6f;
constexpr float LAMBDA_INIT0 = 0.2f;
constexpr float LAMBDA_INIT1 = 0.35550906759f;
__host__ __device__ __forceinline__ float lambda_init(int l) { return l == 0 ? LAMBDA_INIT0 : LAMBDA_INIT1; }

__device__ __forceinline__ unsigned f2bf(float f) { unsigned u = __builtin_bit_cast(unsigned, f); return (u + 0x7fffu + ((u >> 16) & 1u)) >> 16; }
__device__ __forceinline__ float bf2f(unsigned short b) { return __builtin_bit_cast(float, (unsigned)b << 16); }
__device__ __forceinline__ float wave_sum(float v) {
#pragma unroll
    for (int o = 1; o < 64; o <<= 1) v += __shfl_xor(v, o);
    return v;
}
__device__ __forceinline__ float wave_max(float v) {
#pragma unroll
    for (int o = 1; o < 64; o <<= 1) v = fmaxf(v, __shfl_xor(v, o));
    return v;
}
__device__ __forceinline__ float silu(float x) { return x / (1.f + __expf(-x)); }

constexpr size_t MiB = 1u << 20;
constexpr size_t WS_CTL = 0;
constexpr size_t WS_TAB = 64 * 1024;
constexpr size_t WS_BIAS = 192 * 1024;
constexpr size_t WS_LAM = 256 * 1024;
constexpr size_t WS_RSTDSG = 512 * 1024;
constexpr size_t WS_FM = 640 * 1024;
constexpr size_t WS_GM = 704 * 1024;
constexpr size_t WS_WINT = 1 * MiB;
constexpr size_t WS_WOUTT = 54 * MiB;
constexpr size_t WS_WF2T = 70 * MiB;
constexpr size_t WS_XN = 72 * MiB;
constexpr size_t WS_PROJ = 104 * MiB;
constexpr size_t WS_TP = 208 * MiB;
constexpr size_t WS_X2 = 224 * MiB;
constexpr size_t WS_Y = 240 * MiB;
constexpr size_t WS_YOUT = 272 * MiB;
constexpr size_t WS_END = 336 * MiB;

#define LAS __attribute__((address_space(3)))
#define GAS __attribute__((address_space(1)))
typedef unsigned v4u __attribute__((ext_vector_type(4)));
constexpr int NTHR = 512, NWAVES = 8;
constexpr int LDS_BYTES = 147456;
#define LDS_WAIT() asm volatile("s_waitcnt lgkmcnt(0)" ::: "memory")
__device__ __forceinline__ unsigned pk2(float lo, float hi) { return f2bf(lo) | (f2bf(hi) << 16); }

__device__ __forceinline__ void p0_transpose_item(const float* W, int K, int N, bf16* WT, LAS float* scr, int item, int lane) {
    const int nblk = N / 32, kb = item / nblk, nb = item % nblk, k0 = 64 * kb, n0 = 32 * nb;
    float tv[32];
#pragma unroll
    for (int i = 0; i < 32; ++i) { const int kk = 2 * i + (lane >> 5); tv[i] = W[(size_t)(k0 + kk) * N + n0 + (lane & 31)]; }
#pragma unroll
    for (int i = 0; i < 32; ++i) { const int kk = 2 * i + (lane >> 5); scr[kk * 33 + (lane & 31)] = tv[i]; }
    if (0) for (int i = 0; i < 32; ++i) { const int kk = 2 * i + (lane >> 5); scr[kk * 33 + (lane & 31)] = W[(size_t)(k0 + kk) * N + n0 + (lane & 31)]; }
    LDS_WAIT(); asm volatile("" ::: "memory");
    const int c = lane & 7;
#pragma unroll
    for (int j = 0; j < 4; ++j) { const int n = (lane >> 3) + 8 * j; const LAS float* s = scr + (8 * c) * 33 + n;
        v4u o; o.x = pk2(s[0 * 33], s[1 * 33]); o.y = pk2(s[2 * 33], s[3 * 33]); o.z = pk2(s[4 * 33], s[5 * 33]); o.w = pk2(s[6 * 33], s[7 * 33]);
        *(v4u*)(WT + (size_t)(n0 + n) * K + k0 + 8 * c) = o; }
    LDS_WAIT(); asm volatile("" ::: "memory");
}
__device__ __forceinline__ void rms_row_to_bf16(const float4 (&v)[8], const float* gain, bf16* xnrow, int lane) {
    float ss = 0.f;
#pragma unroll
    for (int j = 0; j < 8; ++j) ss += v[j].x * v[j].x + v[j].y * v[j].y + v[j].z * v[j].z + v[j].w * v[j].w;
    const float rstd = rsqrtf(wave_sum(ss) * (1.f / DM) + EPS);
    const float4* gr = (const float4*)gain + lane; uint2* o = (uint2*)xnrow + lane;
#pragma unroll
    for (int j = 0; j < 8; ++j) { const float4 g = gr[64 * j];
        o[64 * j] = make_uint2(pk2(v[j].x * rstd * g.x, v[j].y * rstd * g.y), pk2(v[j].z * rstd * g.z, v[j].w * rstd * g.w)); }
}
#define GTID ((int)(blockIdx.x * NTHR) + fresh_tid())
#define GSIZE ((int)(gridDim.x * NTHR))
#define GWAVE ((int)(blockIdx.x * NWAVES) + (fresh_tid() >> 6))
#define GNWAVES ((int)(gridDim.x * NWAVES))
__device__ __forceinline__ int t5_bucket(int rel) {
    const int ret = rel > 0 ? 16 : 0; const int n = rel < 0 ? -rel : rel;
    if (n < 8) return ret + n;
    int j = 0; while (j < 7 && (64 << (j + 1)) <= n * n) ++j;
    return ret + 8 + j;
}
__device__ __forceinline__ void ph_wf2(const float* __restrict__ wf, bf16* __restrict__ Wf2T, const float* cs128  ) {
    for (int idx = GTID; idx < 512 * 1024; idx += GSIZE) {
        const int j = idx >> 10, pc = idx & 1023, part = pc >> 9, c = pc & 511, g = c >> 7, n3 = c & 127;
        const float* wp = wf + (size_t)(g * 128) * 512 + j; float acc = 0.f;
#pragma unroll 8
        for (int k3 = 0; k3 < 128; ++k3) { acc += cs128[part * 128 + ((k3 * n3) & 127)] * wp[(size_t)k3 * 512]; }
        Wf2T[idx] = (bf16)f2bf(acc * 9.765625e-4f); }
}
__device__ __forceinline__ void ph_tables(const float* __restrict__ rel_bias, const float* __restrict__ lambda_qk, float2* __restrict__ trig, float* __restrict__ biasTab, float* __restrict__ biasTab8, float* __restrict__ lam, bf16* __restrict__ Fm, bf16* __restrict__ Gm) {
    for (int idx = GTID; idx < 32768; idx += GSIZE) {
        { const int row = idx >> 7, n1 = idx & 127, w = row >> 5, i = row & 31, k1 = 16 * w + (i & 7) + 8 * (i >> 4), part = (i >> 3) & 1; float sn, cs; sincospif((float)((n1 * k1) & 127) * (1.f / 64.f), &sn, &cs); Fm[idx] = (bf16)f2bf(part ? -sn : cs); }
        if (idx < 16384) { const int row = idx >> 7, k = idx & 127, wq = row >> 5, i = row & 31, k2 = 16 * wq + (i & 7) + 8 * (i >> 4), pout = (i >> 3) & 1, n2 = k >> 1, pin = k & 1; float sn, cs; sincospif((float)((n2 * k2) & 63) * (1.f / 32.f), &sn, &cs); Gm[idx] = (bf16)f2bf(pout == pin ? cs : (pout == 0 ? sn : -sn)); }
        if (idx < 8192) { float sn, cs; sincospif((float)idx * (1.f / 4096.f), &sn, &cs); trig[idx] = make_float2(cs, sn); }
        if (idx < 8 * 272) { const int h = idx / 272, i = idx % 272; int rel = i - 128; if (rel > 128) rel = 128; const float bv = rel_bias[t5_bucket(rel) * 8 + h]; biasTab[idx] = bv; }
        if (idx < 8 * 520) { const int h = idx / 520, i = idx % 520; float v;
            if (i < 512) { int rel = i - 256; rel = rel < -128 ? -128 : (rel > 128 ? 128 : rel); v = rel_bias[t5_bucket(rel) * 8 + h]; }
            else { v = rel_bias[h]; for (int b = 1; b < 32; ++b) v = fmaxf(v, rel_bias[b * 8 + h]); }
            biasTab8[idx] = 1.4426950408889634f * v; }
        if (idx < 2) { const float* lq = lambda_qk + idx * 256; float a = 0.f, b = 0.f; for (int i = 0; i < 64; ++i) { a += lq[i] * lq[64 + i]; b += lq[128 + i] * lq[192 + i]; }
            lam[idx] = expf(a) - expf(b) + lambda_init(idx); } }
}
__device__ __forceinline__ void ph_f1_naive(const bf16* __restrict__ proj, const float2* __restrict__ trig, bf16* __restrict__ Tp) {
    for (int idx = GTID; idx < 128 * 64 * 512; idx += GSIZE) { const int c = idx & 511, n2 = (idx >> 9) & 63, k1 = idx >> 15;
        float tr = 0.f, ti = 0.f;
        for (int n1 = 0; n1 < 128; ++n1) { const float a = bf2f(proj[(size_t)(64 * n1 + n2) * DIN + OFF_AIN + c]); const float2 cs = trig[((n1 * k1) & 127) * 64]; tr += a * cs.x; ti -= a * cs.y; }
        const float2 tw = trig[k1 * n2];
        const float pr = tr * tw.x + ti * tw.y, pi = ti * tw.x - tr * tw.y;
        Tp[((size_t)(k1 * 64 + n2) * 2 + 0) * 512 + c] = (bf16)f2bf(pr); Tp[((size_t)(k1 * 64 + n2) * 2 + 1) * 512 + c] = (bf16)f2bf(pi); }
}
__device__ __forceinline__ void ph_f2_naive(const bf16* __restrict__ Tp, const float2* __restrict__ trig, bf16* __restrict__ X2) {
    for (int idx = GTID; idx < 128 * 64 * 512; idx += GSIZE) { const int c = idx & 511, k2 = (idx >> 9) & 63, k1 = idx >> 15;
        float xr = 0.f, xi = 0.f;
        for (int n2 = 0; n2 < 64; ++n2) { const float tr = bf2f(Tp[((size_t)(k1 * 64 + n2) * 2 + 0) * 512 + c]), ti = bf2f(Tp[((size_t)(k1 * 64 + n2) * 2 + 1) * 512 + c]);
            const float2 cs = trig[((n2 * k2) & 63) * 128]; xr += tr * cs.x + ti * cs.y; xi += ti * cs.x - tr * cs.y; }
        X2[(size_t)(k1 * 64 + k2) * 1024 + c] = (bf16)f2bf(xr); X2[(size_t)(k1 * 64 + k2) * 1024 + 512 + c] = (bf16)f2bf(xi); }
}
__device__ __forceinline__ void ph_ya_naive(const bf16* __restrict__ X2, const bf16* __restrict__ Wf2T, const bf16* __restrict__ proj, bf16* __restrict__ Y) {
    for (int idx = GTID; idx < 8192 * 512; idx += GSIZE) { const int j = idx & 511, rho = idx >> 9, k1 = rho >> 6, k2 = rho & 63, row = k1 + 128 * k2;
        float acc = 0.f;
        for (int pc = 0; pc < 1024; ++pc) acc += bf2f(X2[(size_t)rho * 1024 + pc]) * bf2f(Wf2T[(size_t)j * 1024 + pc]);
        Y[(size_t)row * DM + j] = (bf16)f2bf(acc * silu(bf2f(proj[(size_t)row * DIN + OFF_AG + j]))); }
}
__device__ __forceinline__ void ph_sgu_rstd(const bf16* __restrict__ proj, float* __restrict__ rstd_sg) {
    for (int idx = GTID; idx < 8192 * 4; idx += GSIZE) { const int g = idx & 3, pos = idx >> 2;
        float ss = 0.f; for (int c = 0; c < 128; ++c) { const float v = bf2f(proj[(size_t)pos * DIN + OFF_VS + g * 128 + c]); ss += v * v; }
        rstd_sg[idx] = rsqrtf(ss * (1.f / 128.f) + EPS); }
}
__device__ __forceinline__ void ph_sgu_naive(const bf16* __restrict__ proj, const float* __restrict__ rstd_sg, const float* __restrict__ vgain, const float* __restrict__ ws, const float* __restrict__ bs, bf16* __restrict__ Y) {
    for (int idx = GTID; idx < 8192 * 512; idx += GSIZE) { const int gc = idx & 511, p = idx >> 9, g = gc >> 7, pp = p & 127, ch = p >> 7;
        float acc = 0.f; const float gn = vgain[gc];
        for (int q = 0; q < 128; ++q) { const int pos = ch * 128 + q; acc += ws[(size_t)(g * 128 + pp) * 128 + q] * (bf2f(proj[(size_t)pos * DIN + OFF_VS + gc]) * rstd_sg[pos * 4 + g] * gn); }
        const float mixed = acc + bs[g * 128 + pp];
        const float u = bf2f(proj[(size_t)p * DIN + OFF_U + gc]);
        Y[(size_t)p * DM + 1536 + gc] = (bf16)f2bf(u * mixed * silu(bf2f(proj[(size_t)p * DIN + OFF_CG + gc]))); }
}
__device__ __forceinline__ void ph_attn_naive(const bf16* __restrict__ proj, const float* __restrict__ biasTab, const float* __restrict__ lamp, const float* __restrict__ ogain, int layer, bf16* __restrict__ Y) {
  const int lane = fresh_tid() & 63;
  for (int w = GWAVE; w < NH * S_; w += GNWAVES) { const int h = w >> 13, q = w & 8191;
    float qv[128];
    { const bf16* qp = proj + (size_t)q * DIN + OFF_Q + h * 128;
#pragma unroll
      for (int d = 0; d < 128; ++d) qv[d] = bf2f(qp[d]) * 0.125f; }
    const float* bt = biasTab + h * 272 + 128;
    float m0 = -1e30f, m1 = -1e30f, l0 = 0.f, l1 = 0.f;
    for (int t = 0; t < 128; ++t) { const int k = t * 64 + lane; const uint4* kp = (const uint4*)(proj + (size_t)k * DIN + OFF_K + h * 128);
        float s0 = 0.f, s1 = 0.f;
#pragma unroll
        for (int i = 0; i < 16; ++i) { const uint4 kk = kp[i]; const unsigned wv[4] = {kk.x, kk.y, kk.z, kk.w};
#pragma unroll
            for (int e = 0; e < 4; ++e) { const float a = __builtin_bit_cast(float, wv[e] << 16), b = __builtin_bit_cast(float, wv[e] & 0xffff0000u);
                if (i < 8) s0 += qv[i * 8 + e * 2] * a + qv[i * 8 + e * 2 + 1] * b; else s1 += qv[i * 8 + e * 2] * a + qv[i * 8 + e * 2 + 1] * b; } }
        int rel = k - q; rel = rel < -128 ? -128 : (rel > 128 ? 128 : rel); const float b = bt[rel]; s0 += b; s1 += b;
        { const float mn = fmaxf(m0, s0); l0 = l0 * __expf(m0 - mn) + __expf(s0 - mn); m0 = mn; }
        { const float mn = fmaxf(m1, s1); l1 = l1 * __expf(m1 - mn) + __expf(s1 - mn); m1 = mn; } }
    { const float M0 = wave_max(m0), M1 = wave_max(m1); l0 = wave_sum(l0 * __expf(m0 - M0)); l1 = wave_sum(l1 * __expf(m1 - M1)); m0 = M0; m1 = M1; }
    const float lam = lamp[layer], il0 = 1.f / l0, il1 = lam / l1;
    float acc0 = 0.f, acc1 = 0.f;
    for (int t = 0; t < 128; ++t) { const int k = t * 64 + lane; const uint4* kp = (const uint4*)(proj + (size_t)k * DIN + OFF_K + h * 128);
        float s0 = 0.f, s1 = 0.f;
#pragma unroll
        for (int i = 0; i < 16; ++i) { const uint4 kk = kp[i]; const unsigned wv[4] = {kk.x, kk.y, kk.z, kk.w};
#pragma unroll
            for (int e = 0; e < 4; ++e) { const float a = __builtin_bit_cast(float, wv[e] << 16), b = __builtin_bit_cast(float, wv[e] & 0xffff0000u);
                if (i < 8) s0 += qv[i * 8 + e * 2] * a + qv[i * 8 + e * 2 + 1] * b; else s1 += qv[i * 8 + e * 2] * a + qv[i * 8 + e * 2 + 1] * b; } }
        int rel = k - q; rel = rel < -128 ? -128 : (rel > 128 ? 128 : rel); const float b = bt[rel]; s0 += b; s1 += b;
        const float wgt = __expf(s0 - m0) * il0 - __expf(s1 - m1) * il1;
        const unsigned* vp = (const unsigned*)(proj + (size_t)(t * 64) * DIN + OFF_V + h * 128) + lane;
        for (int kk = 0; kk < 64; ++kk) { const float wk = __shfl(wgt, kk); const unsigned vv = vp[(size_t)kk * (DIN / 2)];
            acc0 += wk * __builtin_bit_cast(float, vv << 16); acc1 += wk * __builtin_bit_cast(float, vv & 0xffff0000u); } }
    const float rstd = rsqrtf(wave_sum(acc0 * acc0 + acc1 * acc1) * (1.f / 128.f) + EPS) * (1.f - lambda_init(layer));
    const int col = h * 128 + 2 * lane;
    const float y0 = acc0 * rstd * ogain[col] * silu(bf2f(proj[(size_t)q * DIN + OFF_BG + col]));
    const float y1 = acc1 * rstd * ogain[col + 1] * silu(bf2f(proj[(size_t)q * DIN + OFF_BG + col + 1]));
    *(unsigned*)(Y + (size_t)q * DM + 512 + col) = f2bf(y0) | (f2bf(y1) << 16);
  }
}
__device__ __forceinline__ void ph_kmax(const bf16* __restrict__ proj, unsigned* __restrict__ kmax2) {
    for (int idx = GTID; idx < 16 * S_; idx += GSIZE) { const int hm = idx >> 13, key = idx & 8191; const uint4* kp = (const uint4*)(proj + (size_t)key * DIN + OFF_K + hm * 64);
        float ss = 0.f;
#pragma unroll
        for (int i = 0; i < 8; ++i) { const uint4 kk = kp[i]; const unsigned w[4] = {kk.x, kk.y, kk.z, kk.w};
#pragma unroll
            for (int e = 0; e < 4; ++e) { const float a = __builtin_bit_cast(float, w[e] << 16), b = __builtin_bit_cast(float, w[e] & 0xffff0000u); ss += a * a + b * b; } }
        ss = wave_max(ss);
        if ((threadIdx.x & 63) == 0) atomicMax(kmax2 + hm, __builtin_bit_cast(unsigned, ss)); }
}
namespace dattn {
using bf16x8 = __attribute__((ext_vector_type(8))) short;
using s16x4  = __attribute__((ext_vector_type(4))) short;
using f32x16 = __attribute__((ext_vector_type(16))) float;
using u32x4  = __attribute__((ext_vector_type(4))) unsigned;
using f32x4v = __attribute__((ext_vector_type(4))) float;
constexpr int QBLK = 32, KVBLK = 64;
constexpr float SCALE = 0.125f, THR = 8.f;
#ifndef DATTN_SDEPTH
#define DATTN_SDEPTH 1
#endif
constexpr int SDEPTH = DATTN_SDEPTH;
constexpr size_t SHM_V = KVBLK * 128 * 2, SHM_K = KVBLK * 128 * 2, SHM_ATTN = 2 * SHM_V + 2 * SHM_K + 8 * 64 * 4;
#define KSWZ(row, colB) ((row) * 256 + ((colB) ^ (((row) & 7) << 4)))
#define SBAR() __builtin_amdgcn_sched_barrier(0)
__device__ __forceinline__ int crow(int r, int hi) { return (r & 3) + 8 * (r >> 2) + 4 * hi; }
__device__ __forceinline__ unsigned cvtpk(float lo, float hi) { unsigned r; asm volatile("v_cvt_pk_bf16_f32 %0, %1, %2" : "=v"(r) : "v"(lo), "v"(hi)); return r; }
__device__ __forceinline__ void partialSM(f32x16& p0) {
  for (int r = 0; r < 16; ++r) p0[r] = __builtin_amdgcn_exp2f(p0[r]);
}
__device__ __forceinline__ void finishSM(f32x16& p0, f32x16& p1, float& l_reg, bf16x8& pa0, bf16x8& pa1, bf16x8& pa2, bf16x8& pa3) {
  for (int r = 0; r < 16; ++r) p1[r] = __builtin_amdgcn_exp2f(p1[r]);
  float ps = 0; for (int r = 0; r < 16; ++r) ps += p0[r]; for (int r = 0; r < 16; ++r) ps += p1[r];
  l_reg += ps;
#define PK4(P, BASE, OUT) do { unsigned a0 = cvtpk(P[BASE + 0], P[BASE + 1]), a1 = cvtpk(P[BASE + 2], P[BASE + 3]);   \
    unsigned b0 = cvtpk(P[BASE + 4], P[BASE + 5]), b1 = cvtpk(P[BASE + 6], P[BASE + 7]);                              \
    auto r0 = __builtin_amdgcn_permlane32_swap(a0, b0, false, false); auto r1 = __builtin_amdgcn_permlane32_swap(a1, b1, false, false); \
    u32x4 w = {r0[0], r1[0], r0[1], r1[1]}; OUT = *reinterpret_cast<bf16x8*>(&w); } while (0)
  PK4(p0, 0, pa0); PK4(p0, 8, pa1); PK4(p1, 0, pa2); PK4(p1, 8, pa3);
#undef PK4
}
template <bool NEAR> __device__ __forceinline__ void qkt(f32x16& p0, f32x16& p1, const bf16* Ks, const bf16x8* qr, bf16x8 ksh, bf16x8 qsh, int r32, int hi, int cbase) {
  if constexpr (NEAR) { p0 = __builtin_amdgcn_mfma_f32_32x32x16_bf16(ksh, qsh, p0, 0, 0, 0); p1 = __builtin_amdgcn_mfma_f32_32x32x16_bf16(ksh, qsh, p1, 0, 0, 0); }
  else { p0 = __builtin_amdgcn_mfma_f32_32x32x16_bf16(ksh, qsh, f32x16{}, 0, 0, 0); p1 = __builtin_amdgcn_mfma_f32_32x32x16_bf16(ksh, qsh, f32x16{}, 0, 0, 0); }
#pragma unroll
  for (int d0 = 0; d0 < 4; ++d0) { int cb = (cbase + d0 * 16 + hi * 8) * 2;
    bf16x8 b0 = *reinterpret_cast<const bf16x8*>((const char*)Ks + KSWZ(r32, cb));
    bf16x8 b1 = *reinterpret_cast<const bf16x8*>((const char*)Ks + KSWZ(32 + r32, cb));
    p0 = __builtin_amdgcn_mfma_f32_32x32x16_bf16(b0, qr[d0], p0, 0, 0, 0); p1 = __builtin_amdgcn_mfma_f32_32x32x16_bf16(b1, qr[d0], p1, 0, 0, 0); }
}
__device__ __forceinline__ int v_st(int k, int c) { const int kk = (k & ~0xC) | ((k & 4) << 1) | ((k & 8) >> 1); return ((kk >> 3) * 4 + (c >> 5)) * 512 + ((kk & 7) * 32 + (c & 31)) * 2; }
__device__ __forceinline__ int v_rd_base(int lane) { return ((lane & 3) << 3) | (((lane >> 2) & 3) << 6) | (((lane >> 4) & 1) << 5) | (((lane >> 5) & 1) << 8); }
constexpr int v_rd_off(int d0, int ks, int half) { return d0 * 512 + ks * 4096 + half * 2048; }
template <int OFF> __device__ __forceinline__ s16x4 tr_read(int vb) {
  s16x4 r; asm volatile("ds_read_b64_tr_b16 %0, %1 offset:%2" : "=&v"(r) : "v"(vb), "i"(OFF) : "memory"); return r;
}
template <int D0> __device__ __forceinline__ void pv_one(f32x16& od, int vb, bf16x8 pa0, bf16x8 pa1, bf16x8 pa2, bf16x8 pa3) {
  const s16x4 l0 = tr_read<v_rd_off(D0, 0, 0)>(vb), h0 = tr_read<v_rd_off(D0, 0, 1)>(vb), l1 = tr_read<v_rd_off(D0, 1, 0)>(vb), h1 = tr_read<v_rd_off(D0, 1, 1)>(vb);
  const s16x4 l2 = tr_read<v_rd_off(D0, 2, 0)>(vb), h2 = tr_read<v_rd_off(D0, 2, 1)>(vb), l3 = tr_read<v_rd_off(D0, 3, 0)>(vb), h3 = tr_read<v_rd_off(D0, 3, 1)>(vb);
  asm volatile("s_waitcnt lgkmcnt(0)" ::: "memory"); SBAR();
#define PK(L, H) (bf16x8){L[0], L[1], L[2], L[3], H[0], H[1], H[2], H[3]}
  od = __builtin_amdgcn_mfma_f32_32x32x16_bf16(pa0, PK(l0, h0), od, 0, 0, 0);
  od = __builtin_amdgcn_mfma_f32_32x32x16_bf16(pa1, PK(l1, h1), od, 0, 0, 0);
  od = __builtin_amdgcn_mfma_f32_32x32x16_bf16(pa2, PK(l2, h2), od, 0, 0, 0);
  od = __builtin_amdgcn_mfma_f32_32x32x16_bf16(pa3, PK(l3, h3), od, 0, 0, 0);
#undef PK
}
__device__ __forceinline__ void pv_d0(f32x16* o, int vb, bf16x8 pa0, bf16x8 pa1, bf16x8 pa2, bf16x8 pa3) {
  pv_one<0>(o[0], vb, pa0, pa1, pa2, pa3); pv_one<1>(o[1], vb, pa0, pa1, pa2, pa3); pv_one<2>(o[2], vb, pa0, pa1, pa2, pa3); pv_one<3>(o[3], vb, pa0, pa1, pa2, pa3);
}
__device__ __forceinline__ void near_init(f32x16& c0, f32x16& c1, int k0, int qpos, const float* btl, int hi) {
  const float* b = btl + (256 + k0 - qpos + 4 * hi);
#pragma unroll
  for (int r = 0; r < 16; ++r) { c0[r] = b[(r & 3) + 8 * (r >> 2)]; c1[r] = b[(r & 3) + 8 * (r >> 2) + 32]; }
}

__device__ __forceinline__ void dattn_unit(int h, int qb, const bf16* __restrict__ proj, const float* __restrict__ bt2, const unsigned* __restrict__ kmax2, float lam, float oscale, const float* __restrict__ ogain, bf16* __restrict__ Y, char* lds) {
  const int tid = fresh_tid(), wid = __builtin_amdgcn_readfirstlane(tid >> 6), lane = tid & 63, r32 = lane & 31, hi = lane >> 5, cmap = wid >> 2, wq = wid & 3;
  const int qwave = qb * 128 + wq * QBLK, qpos = qwave + r32;
  bf16* V_lds = (bf16*)lds; bf16* K_lds = (bf16*)(lds + 2 * SHM_V);
  float* wsf = (float*)(lds + 2 * SHM_V + 2 * SHM_K) + wid * 64; float* li_l = wsf;
  float l_reg = 0; f32x16 o[4] = {}; bf16x8 qr[4];
  float* btl = (float*)(lds + 69632);
  btl[tid] = bt2[tid];
  float m2;
  { const bf16* Qw = proj + (size_t)qpos * DIN + OFF_Q + h * 128 + cmap * 64 + hi * 8; constexpr float C = SCALE * 1.4426950408889634f; float qq = 0.f;
#pragma unroll
    for (int d0 = 0; d0 < 4; ++d0) { const u32x4 raw = *reinterpret_cast<const u32x4*>(Qw + d0 * 16); const unsigned w[4] = {raw.x, raw.y, raw.z, raw.w}; unsigned pk[4];
#pragma unroll
      for (int e = 0; e < 4; ++e) { const float a = __builtin_bit_cast(float, w[e] << 16) * C, b = __builtin_bit_cast(float, w[e] & 0xffff0000u) * C; pk[e] = cvtpk(a, b);
        const float ar = __builtin_bit_cast(float, pk[e] << 16), br = __builtin_bit_cast(float, pk[e] & 0xffff0000u); qq += ar * ar + br * br; }
      u32x4 q4 = {pk[0], pk[1], pk[2], pk[3]}; qr[d0] = *reinterpret_cast<bf16x8*>(&q4); }
    qq += __shfl_xor(qq, 32);
    m2 = sqrtf(qq * __builtin_bit_cast(float, kmax2[cmap])); }
  const bf16* Kh = proj + OFF_K + h * 128; const bf16* Vh = proj + OFF_V + h * 128;
  const float fL = __builtin_amdgcn_exp2f(bt2[0]), fR = __builtin_amdgcn_exp2f(-bt2[511]);
  bf16x8 ksh, qsh;
  { const unsigned one = hi == 0 ? 0x3f80u : 0u; u32x4 k4 = {one, 0u, 0u, 0u}; ksh = *reinterpret_cast<bf16x8*>(&k4);
    const unsigned nm = hi == 0 ? (cvtpk(-m2, 0.f) & 0xffffu) : 0u; u32x4 q4 = {nm, 0u, 0u, 0u}; qsh = *reinterpret_cast<bf16x8*>(&q4); }
  const int cbase = cmap * 64;
  const int sr = tid >> 4, sc = (tid & 15) * 8, vst0 = v_st(sr, sc), vst1 = v_st(32 + sr, sc);
  const int vb0 = (int)(uintptr_t)V_lds + v_rd_base(lane);
  struct { bf16x8 vs0, vs1, ks0, ks1; } sr_[SDEPTH];
#define LD8(p) (*reinterpret_cast<const bf16x8*>(p))
#define SLOAD(i, k0) do { sr_[i].vs0 = LD8(&Vh[(size_t)((k0) + sr) * DIN + sc]); sr_[i].vs1 = LD8(&Vh[(size_t)((k0) + 32 + sr) * DIN + sc]); \
    sr_[i].ks0 = LD8(&Kh[(size_t)((k0) + sr) * DIN + sc]); sr_[i].ks1 = LD8(&Kh[(size_t)((k0) + 32 + sr) * DIN + sc]); } while (0)
#define SWRITE(b, i) do { *(bf16x8*)((char*)V_lds + (b) * SHM_V + vst0) = sr_[i].vs0;          \
    *(bf16x8*)((char*)V_lds + (b) * SHM_V + vst1) = sr_[i].vs1; int kc = sc * 2;               \
    *(bf16x8*)((char*)K_lds + (b) * SHM_K + KSWZ(sr, kc)) = sr_[i].ks0;                       \
    *(bf16x8*)((char*)K_lds + (b) * SHM_K + KSWZ(32 + sr, kc)) = sr_[i].ks1; } while (0)
#define SWAIT() do { if constexpr (SDEPTH == 2) asm volatile("s_waitcnt vmcnt(4)" ::: "memory"); else asm volatile("s_waitcnt vmcnt(0)" ::: "memory"); } while (0)
  const int tN0 = qwave >= 191 ? (qwave - 191) / 64 + 1 : 0;
  const int tR0 = (qwave + 31 + 128 + 63) / 64;
#define QKT(P0, P1, KB, t) do { if ((t) >= tN0 && (t) < tR0) { near_init(P0, P1, (t) * KVBLK, qpos, btl, hi); SBAR(); qkt<true>(P0, P1, KB, qr, ksh, qsh, r32, hi, cbase); } \
    else { SBAR(); qkt<false>(P0, P1, KB, qr, ksh, qsh, r32, hi, cbase); } } while (0)
#define EDGE(t) do { if (((t) == tN0 && tN0 > 0) || (t) == tR0) { const float f_ = (t) == tR0 ? fR : fL; l_reg *= f_; \
    for (int d_ = 0; d_ < 4; ++d_) for (int r_ = 0; r_ < 16; ++r_) o[d_][r_] *= f_; } } while (0)
  f32x16 pA0, pA1, pB0, pB1; bf16x8 pa0, pa1, pa2, pa3; constexpr int NT = S_ / KVBLK;
  constexpr int SE = 0, SO = SDEPTH - 1;
  SLOAD(SE, 0); asm volatile("s_waitcnt vmcnt(0)" ::: "memory"); SWRITE(0, SE); __syncthreads();
  QKT(pA0, pA1, K_lds, 0); partialSM(pA0);
  SLOAD(SO, KVBLK); if constexpr (SDEPTH == 2) SLOAD(SE, 2 * KVBLK);
  SWAIT(); SWRITE(1, SO); __syncthreads();
  for (int j = 1; j + 1 < NT; j += 2) {
    QKT(pB0, pB1, (bf16*)((char*)K_lds + SHM_K), j);
    finishSM(pA0, pA1, l_reg, pa0, pa1, pa2, pa3); SBAR();
    SLOAD(SO, (j + SDEPTH) * KVBLK); SBAR();
    pv_d0(o, vb0, pa0, pa1, pa2, pa3); EDGE(j); partialSM(pB0);
    __syncthreads(); SWAIT(); SWRITE(0, SE);
    __syncthreads();
    QKT(pA0, pA1, K_lds, j + 1);
    finishSM(pB0, pB1, l_reg, pa0, pa1, pa2, pa3); SBAR();
    if (SDEPTH == 1 || j + 3 < NT) SLOAD(SE, (j + 1 + SDEPTH) * KVBLK); SBAR();
    pv_d0(o, vb0 + (int)SHM_V, pa0, pa1, pa2, pa3); EDGE(j + 1); partialSM(pA0);
    __syncthreads(); SWAIT(); SWRITE(1, SO);
    __syncthreads();
  }
  QKT(pB0, pB1, (bf16*)((char*)K_lds + SHM_K), NT - 1);
  finishSM(pA0, pA1, l_reg, pa0, pa1, pa2, pa3); SBAR();
  pv_d0(o, vb0, pa0, pa1, pa2, pa3); EDGE(NT - 1); partialSM(pB0);
  __syncthreads();
  finishSM(pB0, pB1, l_reg, pa0, pa1, pa2, pa3); SBAR();
  pv_d0(o, vb0 + (int)SHM_V, pa0, pa1, pa2, pa3);
  l_reg += __shfl_xor(l_reg, 32);
  if (hi == 0) li_l[r32] = l_reg; asm volatile("s_waitcnt lgkmcnt(0)" ::: "memory");
  { const float f = cmap ? lam : 1.f;
#pragma unroll
    for (int r = 0; r < 16; ++r) { const float rl = __builtin_amdgcn_rcpf(li_l[crow(r, hi)]) * f;
#pragma unroll
      for (int d0 = 0; d0 < 4; ++d0) o[d0][r] *= rl; } }
  __syncthreads();
  float* X = (float*)lds + wq * 4224;
  if (cmap == 1) {
#pragma unroll
    for (int d0 = 0; d0 < 4; ++d0)
#pragma unroll
      for (int r = 0; r < 16; ++r) X[(d0 * 16 + r) * 64 + lane] = o[d0][r];
  }
  __syncthreads();
  if (cmap == 0) {
    float ss[16];
#pragma unroll
    for (int r = 0; r < 16; ++r) { float s = 0.f;
#pragma unroll
      for (int d0 = 0; d0 < 4; ++d0) { const float v = o[d0][r] - X[(d0 * 16 + r) * 64 + lane]; o[d0][r] = v; s += v * v; }
      ss[r] = s; }
#pragma unroll
    for (int r = 0; r < 16; ++r) { float s = ss[r]; s += __shfl_xor(s, 1); s += __shfl_xor(s, 2); s += __shfl_xor(s, 4); s += __shfl_xor(s, 8); s += __shfl_xor(s, 16);
      ss[r] = rsqrtf(s * (1.f / 128.f) + EPS) * oscale; }
    asm volatile("s_waitcnt lgkmcnt(0)" ::: "memory");
#pragma unroll
    for (int r = 0; r < 16; ++r)
#pragma unroll
      for (int d0 = 0; d0 < 4; ++d0) X[crow(r, hi) * 132 + d0 * 32 + r32] = o[d0][r] * ss[r];
    asm volatile("s_waitcnt lgkmcnt(0)" ::: "memory");
    const int ch = lane & 15;
    const f32x4v g0 = *(const f32x4v*)(ogain + ch * 8), g1 = *(const f32x4v*)(ogain + ch * 8 + 4);
#pragma unroll
    for (int it = 0; it < 8; ++it) { const int row = it * 4 + (lane >> 4);
      const f32x4v a = *(const f32x4v*)(X + row * 132 + ch * 8), b = *(const f32x4v*)(X + row * 132 + ch * 8 + 4);
      const size_t grow = (size_t)(qwave + row);
      const u32x4 bg = *(const u32x4*)(proj + grow * DIN + OFF_BG + h * 128 + ch * 8);
      float y[8] = {a[0] * g0[0], a[1] * g0[1], a[2] * g0[2], a[3] * g0[3], b[0] * g1[0], b[1] * g1[1], b[2] * g1[2], b[3] * g1[3]};
      const unsigned bgw[4] = {bg.x, bg.y, bg.z, bg.w};
#pragma unroll
      for (int e = 0; e < 4; ++e) { y[2 * e] *= silu(__builtin_bit_cast(float, bgw[e] << 16)); y[2 * e + 1] *= silu(__builtin_bit_cast(float, bgw[e] & 0xffff0000u)); }
      u32x4 w = {cvtpk(y[0], y[1]), cvtpk(y[2], y[3]), cvtpk(y[4], y[5]), cvtpk(y[6], y[7])};
      *(u32x4*)(Y + grow * DM + 512 + h * 128 + ch * 8) = w; }
  }
  __syncthreads();
#undef LD8
#undef SLOAD
#undef SWRITE
#undef SWAIT
#undef QKT
#undef EDGE
}
#undef KSWZ
#undef SBAR
}
namespace smm {
using dattn::bf16x8; using dattn::f32x16; using dattn::u32x4; using dattn::f32x4v;
constexpr int TILE = 2 * (int)dattn::SHM_V;
#define SMM_LD8(p) (*reinterpret_cast<const smm::bf16x8*>(p))
__device__ __forceinline__ void mm128(f32x16* o, const bf16* Arow  , int vb) {
#pragma unroll
  for (int t = 0; t < 2; ++t) { const bf16x8 pa0 = SMM_LD8(Arow + t * 64), pa1 = SMM_LD8(Arow + t * 64 + 16), pa2 = SMM_LD8(Arow + t * 64 + 32), pa3 = SMM_LD8(Arow + t * 64 + 48);
    dattn::pv_d0(o, vb + t * (int)dattn::SHM_V, pa0, pa1, pa2, pa3); }
}
__device__ __forceinline__ void f1_item(int n2, int cb, const bf16* __restrict__ proj, const bf16* __restrict__ Fm, const float2* __restrict__ trig, bf16* __restrict__ Tp, char* lds) {
  const int tid = fresh_tid(), wid = tid >> 6, lane = tid & 63, r32 = lane & 31, hi = lane >> 5;
  const int sr = tid >> 4, sc = (tid & 15) * 8;
  { bf16x8 v[4];
#pragma unroll
    for (int p = 0; p < 4; ++p) v[p] = SMM_LD8(proj + (size_t)(64 * (p * 32 + sr) + n2) * DIN + OFF_AIN + cb * 128 + sc);
#pragma unroll
    for (int p = 0; p < 4; ++p) *(bf16x8*)(lds + (p >> 1) * dattn::SHM_V + dattn::v_st((p & 1) * 32 + sr, sc)) = v[p]; }
  __syncthreads();
  f32x16 o[4] = {};
  mm128(o, Fm + (size_t)(wid * 32 + r32) * 128 + hi * 8, (int)(uintptr_t)lds + dattn::v_rd_base(lane));
#pragma unroll
  for (int rr = 0; rr < 8; ++rr) { const int r = (rr & 3) + 8 * (rr >> 2); const int k1 = 16 * wid + (r & 3) + 4 * hi + 8 * (r >> 3);
    const float2 tw = trig[k1 * n2]; bf16* dst = Tp + ((size_t)(k1 * 64 + n2) * 2) * 512 + cb * 128 + r32;
#pragma unroll
    for (int d0 = 0; d0 < 4; ++d0) { const float tr = o[d0][r], ti = o[d0][r + 4];
      dst[d0 * 32] = (bf16)f2bf(tr * tw.x + ti * tw.y); dst[512 + d0 * 32] = (bf16)f2bf(ti * tw.x - tr * tw.y); } }
  __syncthreads();
}
__device__ __forceinline__ void f2_item(int kp, int cb, const bf16* __restrict__ Tp, const bf16* __restrict__ Gm, bf16* __restrict__ X2, char* lds) {
  const int tid = fresh_tid(), wid = tid >> 6, lane = tid & 63, r32 = lane & 31, hi = lane >> 5, wq = wid & 3;
  const int sr = tid >> 4, sc = (tid & 15) * 8;
#pragma unroll
  for (int t2 = 0; t2 < 2; ++t2) { bf16x8 v[4]; const bf16* src = Tp + (size_t)(2 * kp + t2) * 128 * 512 + cb * 128 + sc;
#pragma unroll
    for (int p = 0; p < 4; ++p) v[p] = SMM_LD8(src + (size_t)(p * 32 + sr) * 512);
#pragma unroll
    for (int p = 0; p < 4; ++p) *(bf16x8*)(lds + t2 * TILE + (p >> 1) * dattn::SHM_V + dattn::v_st((p & 1) * 32 + sr, sc)) = v[p]; }
  __syncthreads();
  f32x16 o[4] = {};
  mm128(o, Gm + (size_t)(wq * 32 + r32) * 128 + hi * 8, (int)(uintptr_t)lds + (wid >> 2) * TILE + dattn::v_rd_base(lane));
  const int k1 = 2 * kp + (wid >> 2);
#pragma unroll
  for (int r = 0; r < 16; ++r) { const int k2 = 16 * wq + (r & 3) + 4 * hi + 8 * (r >> 3), part = (r >> 2) & 1;
    bf16* dst = X2 + (size_t)(k1 * 64 + k2) * 1024 + part * 512 + cb * 128 + r32;
#pragma unroll
    for (int d0 = 0; d0 < 4; ++d0) dst[d0 * 32] = (bf16)f2bf(o[d0][r]); }
  __syncthreads();
}
__device__ __forceinline__ void sgu_item(int chk, int gp, const bf16* __restrict__ proj, const float* __restrict__ vgain, const float* __restrict__ wsp, const float* __restrict__ bsp, bf16* __restrict__ Y, char* lds) {
  const int tid = fresh_tid(), wid = tid >> 6, lane = tid & 63, r32 = lane & 31, hi = lane >> 5, wq = wid & 3;
  const int sr = tid >> 4, sc = (tid & 15) * 8;
#pragma unroll
  for (int t2 = 0; t2 < 2; ++t2) { const int g = 2 * gp + t2; u32x4 v[4]; const bf16* src = proj + (size_t)(chk * 128) * DIN + OFF_VS + g * 128 + sc;
#pragma unroll
    for (int p = 0; p < 4; ++p) v[p] = *(const u32x4*)(src + (size_t)(p * 32 + sr) * DIN);
    const f32x4v g0 = *(const f32x4v*)(vgain + g * 128 + sc), g1 = *(const f32x4v*)(vgain + g * 128 + sc + 4);
#pragma unroll
    for (int p = 0; p < 4; ++p) { const unsigned w[4] = {v[p].x, v[p].y, v[p].z, v[p].w}; float f[8]; float ss = 0.f;
#pragma unroll
      for (int e = 0; e < 4; ++e) { f[2 * e] = __builtin_bit_cast(float, w[e] << 16); f[2 * e + 1] = __builtin_bit_cast(float, w[e] & 0xffff0000u); ss += f[2 * e] * f[2 * e] + f[2 * e + 1] * f[2 * e + 1]; }
      ss += __shfl_xor(ss, 1); ss += __shfl_xor(ss, 2); ss += __shfl_xor(ss, 4); ss += __shfl_xor(ss, 8);
      const float rs = rsqrtf(ss * (1.f / 128.f) + EPS);
      u32x4 q = {dattn::cvtpk(f[0] * rs * g0[0], f[1] * rs * g0[1]), dattn::cvtpk(f[2] * rs * g0[2], f[3] * rs * g0[3]), dattn::cvtpk(f[4] * rs * g1[0], f[5] * rs * g1[1]), dattn::cvtpk(f[6] * rs * g1[2], f[7] * rs * g1[3])};
      *(u32x4*)(lds + t2 * TILE + (p >> 1) * dattn::SHM_V + dattn::v_st((p & 1) * 32 + sr, sc)) = q; } }
  __syncthreads();
  const int g = 2 * gp + (wid >> 2);
  f32x16 o[4] = {};
  { const float* Arow = wsp + (size_t)(g * 128 + wq * 32 + r32) * 128 + hi * 8; const int vb = (int)(uintptr_t)lds + (wid >> 2) * TILE + dattn::v_rd_base(lane);
#pragma unroll
    for (int t = 0; t < 2; ++t) { bf16x8 pa[4];
#pragma unroll
      for (int k = 0; k < 4; ++k) { const f32x4v a = *(const f32x4v*)(Arow + t * 64 + k * 16), b = *(const f32x4v*)(Arow + t * 64 + k * 16 + 4);
        u32x4 w = {dattn::cvtpk(a[0], a[1]), dattn::cvtpk(a[2], a[3]), dattn::cvtpk(b[0], b[1]), dattn::cvtpk(b[2], b[3])}; pa[k] = *reinterpret_cast<bf16x8*>(&w); }
      dattn::pv_d0(o, vb + t * (int)dattn::SHM_V, pa[0], pa[1], pa[2], pa[3]); } }
  __syncthreads();
  float* X = (float*)lds + wid * 4224;
#pragma unroll
  for (int r = 0; r < 16; ++r) { const float bb = bsp[g * 128 + wq * 32 + dattn::crow(r, hi)];
#pragma unroll
    for (int d0 = 0; d0 < 4; ++d0) X[dattn::crow(r, hi) * 132 + d0 * 32 + r32] = o[d0][r] + bb; }
  asm volatile("s_waitcnt lgkmcnt(0)" ::: "memory");
  const int c16 = lane & 15;
#pragma unroll
  for (int it = 0; it < 8; ++it) { const int row = it * 4 + (lane >> 4);
    const f32x4v a = *(const f32x4v*)(X + row * 132 + c16 * 8), b = *(const f32x4v*)(X + row * 132 + c16 * 8 + 4);
    const size_t pos = (size_t)(chk * 128 + wq * 32 + row);
    const u32x4 uu = *(const u32x4*)(proj + pos * DIN + OFF_U + g * 128 + c16 * 8), cgv = *(const u32x4*)(proj + pos * DIN + OFF_CG + g * 128 + c16 * 8);
    float y[8] = {a[0], a[1], a[2], a[3], b[0], b[1], b[2], b[3]};
    const unsigned uw[4] = {uu.x, uu.y, uu.z, uu.w}, cw[4] = {cgv.x, cgv.y, cgv.z, cgv.w};
#pragma unroll
    for (int e = 0; e < 4; ++e) { y[2 * e] *= __builtin_bit_cast(float, uw[e] << 16) * silu(__builtin_bit_cast(float, cw[e] << 16));
      y[2 * e + 1] *= __builtin_bit_cast(float, uw[e] & 0xffff0000u) * silu(__builtin_bit_cast(float, cw[e] & 0xffff0000u)); }
    u32x4 w = {dattn::cvtpk(y[0], y[1]), dattn::cvtpk(y[2], y[3]), dattn::cvtpk(y[4], y[5]), dattn::cvtpk(y[6], y[7])};
    *(u32x4*)(Y + pos * DM + 1536 + g * 128 + c16 * 8) = w; }
  __syncthreads();
}
}
struct EpiYa {
    static constexpr bool PERM = true, AFTER_DRAIN = false;
    bf16* Y; const bf16* proj;
    __device__ __forceinline__ void operator()(const pg8::f32x4 (&acc)[2][2][4][2], const pg8::Unit& u, int wr, int wc, int fr, int fq) const {
        const int rho0 = u.pm * pg8::BM + wr * 64 + fr; const int col0 = u.pn * pg8::BM + wc * 32 + 8 * fq;
#pragma unroll
        for (int ai = 0; ai < 2; ++ai)
#pragma unroll
            for (int m = 0; m < 4; ++m) { const int rho = rho0 + ai * pg8::HALF + m * 16; const size_t row = (size_t)((rho >> 6) + 128 * (rho & 63));
#pragma unroll
                for (int bj = 0; bj < 2; ++bj) { const int col = col0 + bj * pg8::HALF; const pg8::f32x4 v0 = acc[ai][bj][m][0], v1 = acc[ai][bj][m][1];
                    const pg8::u32x4 gt = *(const pg8::u32x4*)(proj + row * DIN + OFF_AG + col);
                    const unsigned gw[4] = {gt.x, gt.y, gt.z, gt.w}; float y[8] = {v0[0], v0[1], v0[2], v0[3], v1[0], v1[1], v1[2], v1[3]};
#pragma unroll
                    for (int e = 0; e < 4; ++e) { y[2 * e] *= silu(__builtin_bit_cast(float, gw[e] << 16)); y[2 * e + 1] *= silu(__builtin_bit_cast(float, gw[e] & 0xffff0000u)); }
                    pg8::u32x4 w; w.x = pg8::cvt_pk_bf16(y[0], y[1]); w.y = pg8::cvt_pk_bf16(y[2], y[3]); w.z = pg8::cvt_pk_bf16(y[4], y[5]); w.w = pg8::cvt_pk_bf16(y[6], y[7]);
                    *(pg8::u32x4*)(Y + row * DM + col) = w; } }
    }
};
#include <hip/hip_cooperative_groups.h>
namespace cg = cooperative_groups;
struct Args { const float* in[12]; float* out; unsigned char* ws; };
#define XB_TMO      128
#define XB_XCNT(j)  (256  + 64 * (j))
#define XB_XSUB(j)  (1280 + 64 * (j))
#define XB_XGEN(j)  (2304 + 64 * (j))
#define XB_TOP      3328
#define XB_TOPGEN   3392
#define XCD_BAR_WORDS 3456
#define XB_SPIN_CAP (1u << 18)

__device__ __forceinline__ unsigned xb_ld(unsigned* p)              { return __hip_atomic_load(p, __ATOMIC_RELAXED, __HIP_MEMORY_SCOPE_AGENT); }
__device__ __forceinline__ unsigned xb_add(unsigned* p, unsigned v) { return __hip_atomic_fetch_add(p, v, __ATOMIC_RELAXED, __HIP_MEMORY_SCOPE_AGENT); }
__device__ __forceinline__ unsigned xb_xcc_id() { return (unsigned)__builtin_amdgcn_s_getreg((3 << 11) | 20) & 0xFu; }
#define XB_SPIN(cond, bar) do { unsigned _sp = 0; while (cond) { __builtin_amdgcn_s_sleep(1); \
    if ((++_sp & 255u) == 0u) { if (xb_ld(&(bar)[XB_TMO])) break; if (_sp > XB_SPIN_CAP) { atomicAdd(&(bar)[XB_TMO], 1u); break; } } } } while (0)

struct XcdBarrier {
    unsigned* bar; unsigned x;
    volatile LAS unsigned* st;
};

__device__ __forceinline__ XcdBarrier xcd_barrier_post(unsigned* bar, volatile LAS unsigned* st) {
    XcdBarrier b; b.bar = bar; b.x = xb_xcc_id(); b.st = st;
    if (threadIdx.x == 0) (void)xb_add(&bar[XB_XCNT(b.x)], 1u);
    return b;
}
__device__ __forceinline__ void xcd_barrier_complete(unsigned* bar, unsigned x, unsigned& nloc, unsigned& nx) {
    const unsigned G = gridDim.x * gridDim.y * gridDim.z;
    unsigned sum, cnt, mine, sp = 0u;
    for (;;) {
        sum = 0u; cnt = 0u; mine = 0u;
#pragma unroll
        for (unsigned j = 0; j < 16; ++j) { const unsigned c = xb_ld(&bar[XB_XCNT(j)]); sum += c; cnt += (c > 0u) ? 1u : 0u; mine = (j == x) ? c : mine; }
        if (sum == G) break;
        __builtin_amdgcn_s_sleep(1);
        if ((++sp & 255u) == 0u) { if (xb_ld(&bar[XB_TMO])) break; if (sp > XB_SPIN_CAP) { atomicAdd(&bar[XB_TMO], 1u); break; } }
    }
    nloc = mine > 0u ? mine : 1u; nx = cnt > 0u ? cnt : 1u;
}

__device__ __forceinline__ void xcd_barrier(const XcdBarrier& b) {
    asm volatile("s_waitcnt vmcnt(0)" ::: "memory");
    __syncthreads();
    if (threadIdx.x == 0) {
        unsigned* bar = b.bar;
        __builtin_amdgcn_s_waitcnt(0);
        unsigned nloc = b.st[0], nx = b.st[1];
        if (nloc == 0u) { xcd_barrier_complete(bar, b.x, nloc, nx); b.st[0] = nloc; b.st[1] = nx; }
        const unsigned old = xb_add(&bar[XB_XSUB(b.x)], 1u);
        const unsigned gen = old / nloc;
        if (old + 1u == (gen + 1u) * nloc) {
            __builtin_amdgcn_fence(__ATOMIC_RELEASE, "agent");
            asm volatile("s_waitcnt vmcnt(0)" ::: "memory");
            const unsigned og = xb_add(&bar[XB_TOP], 1u);
            const unsigned tg = og / nx;
            if (og + 1u == (tg + 1u) * nx) xb_add(&bar[XB_TOPGEN], 1u);
            else XB_SPIN(xb_ld(&bar[XB_TOPGEN]) == tg, bar);
            __builtin_amdgcn_fence(__ATOMIC_ACQUIRE, "agent");
            xb_add(&bar[XB_XGEN(b.x)], 1u);
            asm volatile("s_waitcnt vmcnt(0)" ::: "memory");
        } else {
            XB_SPIN(xb_ld(&bar[XB_XGEN(b.x)]) == gen, bar);
            __builtin_amdgcn_fence(__ATOMIC_ACQUIRE, "agent");
            asm volatile("s_waitcnt vmcnt(0)" ::: "memory");
        }
    }
    __syncthreads();
}

constexpr int MISC_OFF = LDS_BYTES - 64;
constexpr int CW_BAR = 1024;
constexpr size_t CTL_ZERO_BYTES = 65536;
#define GRID_SYNC() xcd_barrier(bar)
#ifndef REP_P0
#define REP_P0 1
#endif
#ifndef REP_PA
#define REP_PA 1
#endif
#ifndef REP_PB
#define REP_PB 1
#endif
#ifndef REP_PC
#define REP_PC 1
#endif
#ifndef REP_YA
#define REP_YA 1
#endif
#ifndef REP_AT
#define REP_AT 1
#endif
#ifndef REP_PE
#define REP_PE 1
#endif
typedef const __attribute__((address_space(4))) unsigned char* kargp_t;
#define KARG(i) (*(const volatile __attribute__((address_space(4))) unsigned long long*)(kargs + 8 * (i)))
#define A_IN(i) ((const float*)(const GAS float*)KARG(i))
#define A_X A_IN(0)
#define A_WIN A_IN(1)
#define A_PREG A_IN(2)
#define A_POSTG A_IN(3)
#define A_WF A_IN(4)
#define A_LQK A_IN(5)
#define A_OGAIN A_IN(6)
#define A_VGAIN A_IN(7)
#define A_WS A_IN(8)
#define A_BS A_IN(9)
#define A_WOUT A_IN(10)
#define A_RELB A_IN(11)
#define A_OUT ((float*)(GAS float*)KARG(12))
#define A_WSP ((unsigned char*)(GAS unsigned char*)KARG(13))
#define W_TRIG ((float2*)(A_WSP + WS_TAB))
#define W_BIAS ((float*)(A_WSP + WS_BIAS))
#define W_BIAS8 ((float*)(A_WSP + WS_BIAS + 16384))
#define W_LAM ((float*)(A_WSP + WS_LAM))
#define W_RSTDSG ((float*)(A_WSP + WS_RSTDSG))
#define W_FM ((bf16*)(A_WSP + WS_FM))
#define W_GM ((bf16*)(A_WSP + WS_GM))
#define W_WINT ((bf16*)(A_WSP + WS_WINT))
#define W_WOUTT ((bf16*)(A_WSP + WS_WOUTT))
#define W_WF2T ((bf16*)(A_WSP + WS_WF2T))
#define W_XN ((bf16*)(A_WSP + WS_XN))
#define W_PROJ ((bf16*)(A_WSP + WS_PROJ))
#define W_TP ((bf16*)(A_WSP + WS_TP))
#define W_X2 ((bf16*)(A_WSP + WS_X2))
#define W_Y ((bf16*)(A_WSP + WS_Y))
#define W_YOUT ((float*)(A_WSP + WS_YOUT))
constexpr int I_IN = (DM / 64) * (DIN / 32), I_OUT = (DM / 64) * (DM / 32), I_L = I_IN + I_OUT;
__global__ void __launch_bounds__(NTHR, 2) mega_fwd(Args a) {
    extern __shared__ __attribute__((aligned(16))) unsigned char lds[];
    cg::grid_group grid = cg::this_grid();
    const kargp_t kargs = (kargp_t)__builtin_amdgcn_kernarg_segment_ptr();
    LAS unsigned char* L = (LAS unsigned char*)lds;
    if (threadIdx.x < 16) ((LAS unsigned*)(L + MISC_OFF))[threadIdx.x] = 0u;
    __syncthreads();
    const XcdBarrier bar = xcd_barrier_post((unsigned*)A_WSP + CW_BAR, (volatile LAS unsigned*)(L + MISC_OFF));

    for (int rep = 0; rep < REP_P0; ++rep) {
        const int ftid = fresh_tid(); const int lane = ftid & 63, wave = __builtin_amdgcn_readfirstlane(ftid >> 6);
        const int gw = (int)blockIdx.x * NWAVES + wave, NGW = (int)gridDim.x * NWAVES;
        LAS float* scr = (LAS float*)(L + wave * 16384);
        { const float* w_in = A_WIN; const float* w_out = A_WOUT; bf16* WinT = W_WINT; bf16* WoutT = W_WOUTT;
          for (int it = gw; it < I_L; it += NGW) {
            if (it < I_IN) p0_transpose_item(w_in, DM, DIN, WinT, scr, it, lane);
            else p0_transpose_item(w_out, DM, DM, WoutT, scr, it - I_IN, lane); } }
        __syncthreads();
        { float* cs128 = (float*)lds; if (ftid < 128) { float sn, cs; sincospif((float)ftid * (1.f / 64.f), &sn, &cs); cs128[ftid] = cs; cs128[128 + ftid] = sn; }
          __syncthreads();
          ph_wf2(A_WF, W_WF2T, cs128); ph_wf2(A_WF + (size_t)DF * DF, W_WF2T + (size_t)512 * 1024, cs128);
          __syncthreads(); }
        ph_tables(A_RELB, A_LQK, W_TRIG, W_BIAS, W_BIAS8, W_LAM, W_FM, W_GM);
        { const float* xp = A_X; const float* pg = A_PREG; bf16* XN = W_XN;
          for (int row = gw; row < S_; row += NGW) { const float4* xr = (const float4*)(xp + (size_t)row * DM) + lane; float4 v[8];
#pragma unroll
            for (int j = 0; j < 8; ++j) v[j] = xr[64 * j];
            rms_row_to_bf16(v, pg, XN + (size_t)row * DM, lane); } }
    }
    grid.sync();
#pragma unroll 1
    for (int l = 0; l < DEPTH; ++l) {
        for (int rep = 0; rep < REP_PA; ++rep) { pg8::Gemm g{W_XN, W_WINT + (size_t)l * DIN * DM, S_, DIN, DM}; pg8::StaticOrder S; S.init(S_, DIN, (int)gridDim.x, (int)blockIdx.x);
          pg8::EpiBf16 E{W_PROJ, DIN};
          pg8::gemm_phase<pg8::EpiBf16, pg8::StaticOrder, true, true>(L, g, S, E); }
        if (l == 0) {
            const int nb = (int)gridDim.x - 64;
            if ((int)blockIdx.x >= 64 && nb > 0) { const int ftid = fresh_tid(); const int lane = ftid & 63, wave = __builtin_amdgcn_readfirstlane(ftid >> 6);
                LAS float* scr = (LAS float*)(L + wave * 16384); const float* w_in = A_WIN + (size_t)DM * DIN; const float* w_out = A_WOUT + (size_t)DM * DM; bf16* WinT = W_WINT + (size_t)DIN * DM; bf16* WoutT = W_WOUTT + (size_t)DM * DM;
                for (int it = ((int)blockIdx.x - 64) * NWAVES + wave; it < I_L; it += nb * NWAVES) {
                    if (it < I_IN) p0_transpose_item(w_in, DM, DIN, WinT, scr, it, lane);
                    else p0_transpose_item(w_out, DM, DM, WoutT, scr, it - I_IN, lane); } }
            else if (nb <= 0) {   const int ftid = fresh_tid(); const int lane = ftid & 63, wave = __builtin_amdgcn_readfirstlane(ftid >> 6);
                LAS float* scr = (LAS float*)(L + wave * 16384); const float* w_in = A_WIN + (size_t)DM * DIN; const float* w_out = A_WOUT + (size_t)DM * DM; bf16* WinT = W_WINT + (size_t)DIN * DM; bf16* WoutT = W_WOUTT + (size_t)DM * DM;
                for (int it = (int)blockIdx.x * NWAVES + wave; it < I_L; it += (int)gridDim.x * NWAVES) {
                    if (it < I_IN) p0_transpose_item(w_in, DM, DIN, WinT, scr, it, lane);
                    else p0_transpose_item(w_out, DM, DM, WoutT, scr, it - I_IN, lane); } }
        }
        GRID_SYNC();
#ifdef X_NAIVE_SMALL
        ph_f1_naive(W_PROJ, W_TRIG, W_TP); ph_sgu_rstd(W_PROJ, W_RSTDSG);
        GRID_SYNC();
        ph_f2_naive(W_TP, W_TRIG, W_X2);
        ph_sgu_naive(W_PROJ, W_RSTDSG, A_VGAIN + l * DG, A_WS + (size_t)l * 4 * 128 * 128, A_BS + l * 4 * 128, W_Y);
        GRID_SYNC();
        ph_ya_naive(W_X2, W_WF2T + (size_t)l * 512 * 1024, W_PROJ, W_Y);
#else
        for (int rep = 0; rep < REP_PB; ++rep) { const bf16* proj = W_PROJ; const bf16* Fm = W_FM; const float2* trig = W_TRIG; bf16* Tp = W_TP; bf16* Yp = W_Y;
          const float* vg = A_VGAIN + l * DG; const float* wsp = A_WS + (size_t)l * 4 * 128 * 128; const float* bsp = A_BS + l * 4 * 128;
          for (int it = (int)blockIdx.x; it < 384; it += (int)gridDim.x) {
            if (it < 256) smm::f1_item(it & 63, it >> 6, proj, Fm, trig, Tp, (char*)lds);
            else smm::sgu_item((it - 256) >> 1, (it - 256) & 1, proj, vg, wsp, bsp, Yp, (char*)lds); }
          if (rep == 0) ph_kmax(proj, (unsigned*)A_WSP + 64 + l * 16); }
        GRID_SYNC();
        for (int rep = 0; rep < REP_PC; ++rep) { const bf16* Tp = W_TP; const bf16* Gm = W_GM; bf16* X2 = W_X2;
          for (int it = (int)blockIdx.x; it < 256; it += (int)gridDim.x) smm::f2_item(it & 63, it >> 6, Tp, Gm, X2, (char*)lds); }
        GRID_SYNC();
        for (int rep = 0; rep < REP_YA; ++rep) { pg8::Gemm g{W_X2, W_WF2T + (size_t)l * 512 * 1024, S_, 512, 1024}; pg8::StaticOrder S; S.init(S_, 512, (int)gridDim.x, (int)blockIdx.x);
          EpiYa E{W_Y, W_PROJ};
          pg8::gemm_phase<EpiYa, pg8::StaticOrder, true, true>(L, g, S, E); }
#endif
        for (int rep = 0; rep < REP_AT; ++rep) { const bf16* proj = W_PROJ; const float* bt8 = W_BIAS8; const float lamv = W_LAM[l]; const float* og = A_OGAIN + l * DD; bf16* Yp = W_Y;
          for (int u = (int)blockIdx.x; u < NH * (S_ / 128); u += (int)gridDim.x) { const int hh = u & 7, qb = u >> 3;
            dattn::dattn_unit(hh, qb, proj, bt8 + hh * 520, (const unsigned*)A_WSP + 64 + l * 16 + hh * 2, lamv, 1.f - lambda_init(l), og + hh * 128, Yp, (char*)lds); } }
        GRID_SYNC();
        for (int rep = 0; rep < REP_PE; ++rep) { pg8::Gemm g{W_Y, W_WOUTT + (size_t)l * DM * DM, S_, DM, DM}; pg8::StaticOrder S; S.init(S_, DM, (int)gridDim.x, (int)blockIdx.x);
          pg8::EpiF32 E{W_YOUT, DM};
          pg8::gemm_phase<pg8::EpiF32, pg8::StaticOrder, true, true>(L, g, S, E); }
        GRID_SYNC();
        { const int ftid = fresh_tid(); const int lane = ftid & 63, wave = __builtin_amdgcn_readfirstlane(ftid >> 6);
          const int gw = (int)blockIdx.x * NWAVES + wave, NGW = (int)gridDim.x * NWAVES;
          const float* yo = W_YOUT; const float* pg = A_POSTG + l * DM; const float* xs = (l == 0 ? A_X : (const float*)A_OUT); float* outp = A_OUT; bf16* XN = W_XN; const float* pre = A_PREG + (l + 1 < DEPTH ? (l + 1) * DM : 0);
          for (int row = gw; row < S_; row += NGW) {
            const float4* yr = (const float4*)(yo + (size_t)row * DM) + lane; const float4* gr = (const float4*)pg + lane; const float4* xr = (const float4*)(xs + (size_t)row * DM) + lane;
            float4 v[8]; float ss = 0.f;
#pragma unroll
            for (int j = 0; j < 8; ++j) { v[j] = yr[64 * j]; ss += v[j].x * v[j].x + v[j].y * v[j].y + v[j].z * v[j].z + v[j].w * v[j].w; }
            const float rstd = rsqrtf(wave_sum(ss) * (1.f / DM) + EPS);
            float4* o = (float4*)(outp + (size_t)row * DM) + lane;
#pragma unroll
            for (int j = 0; j < 8; ++j) { const float4 g = gr[64 * j]; const float4 xv = xr[64 * j];
                v[j] = make_float4(xv.x + v[j].x * rstd * g.x, xv.y + v[j].y * rstd * g.y, xv.z + v[j].z * rstd * g.z, xv.w + v[j].w * rstd * g.w); o[64 * j] = v[j]; }
            if (l + 1 < DEPTH) rms_row_to_bf16(v, pre, XN + (size_t)row * DM, lane);
          } }
        if (l + 1 < DEPTH) GRID_SYNC();
    }
}

extern "C" void kernel_launch(void* const* d_in, const int* in_sizes, int n_in, void* d_out, int out_size, void* d_ws, size_t ws_size, hipStream_t stream) {
    static int grid = 0;
    if (grid == 0) {
        if (n_in != 12 || ws_size < WS_END) { fprintf(stderr, "kernel_launch: unexpected n_in %d / ws %zu\n", n_in, ws_size); grid = -1; return; }
        int dev = 0, cus = 0, per_cu = 0;
        if (hipGetDevice(&dev) != hipSuccess || hipDeviceGetAttribute(&cus, hipDeviceAttributeMultiprocessorCount, dev) != hipSuccess) { grid = -1; return; }
        if (hipFuncSetAttribute((const void*)mega_fwd, hipFuncAttributeMaxDynamicSharedMemorySize, LDS_BYTES) != hipSuccess) { fprintf(stderr, "kernel_launch: hipFuncSetAttribute failed\n"); grid = -1; return; }
        if (hipOccupancyMaxActiveBlocksPerMultiprocessor(&per_cu, (const void*)mega_fwd, NTHR, LDS_BYTES) != hipSuccess || per_cu < 1) { fprintf(stderr, "kernel_launch: occupancy query failed (%d)\n", per_cu); (void)hipGetLastError(); grid = -1; return; }
        grid = cus * per_cu;
    }
    if (grid < 0) return;
    if (hipMemsetAsync((char*)d_ws + WS_CTL, 0, CTL_ZERO_BYTES, stream) != hipSuccess) { fprintf(stderr, "kernel_launch: hipMemsetAsync failed\n"); return; }
    Args a{};
    for (int i = 0; i < 12; ++i) a.in[i] = (const float*)d_in[i];
    a.out = (float*)d_out; a.ws = (unsigned char*)d_ws;
    void* args[] = {&a};
    hipError_t e = hipLaunchCooperativeKernel((const void*)mega_fwd, dim3(grid), dim3(NTHR), args, LDS_BYTES, stream);
    if (e != hipSuccess) fprintf(stderr, "cooperative launch failed: %s (grid %d)\n", hipGetErrorString(e), grid);
}
```
